# Optimizing an MI355X kernel written in HIP

```python
import math
import jax, jax.numpy as jnp
from jax import lax
import numpy as np

D_MODEL = 1024
BATCH = 16
SEQ = 2048
DEPTH = 2

GRID_W = 64
CTX_LEN = 256
N_MIXERS = 2
NA_HEADS = 16
NA_HEAD_DIM = D_MODEL // NA_HEADS
NA_WIN_R = 8
NA_WIN_C = 16
NA_QCOLS = 16
NA_KCOLS = NA_QCOLS + NA_WIN_C
DIFF_HEADS = 8
DIFF_HEAD_DIM = 64
DIFF_V_DIM = 2 * DIFF_HEAD_DIM
Q_BLOCK = 128
ROPE_THETA = 10000.0
ROPE_AXIS_DIM = DIFF_HEAD_DIM // 2
D_FF = 2816
N_EXPERTS = 8
TOP_K = 2
D_FF_EXPERT = 3584
NORM_EPS = 1e-6

kernel_name = "hybrid_natten_diffattn_moe_dit"


def rmsnorm(x, g):
    x32 = x.astype(jnp.float32)
    y = x32 * lax.rsqrt(jnp.mean(x32 * x32, axis=-1, keepdims=True) + NORM_EPS)
    return y.astype(x.dtype) * g


def adaln_params(cond, w_ada, b_ada):
    return jnp.split(jax.nn.silu(cond) @ w_ada + b_ada, 6, axis=-1)


def modulate(h, shift, scale):
    return h * (1 + scale) + shift


def swiglu(h, w_gate, w_up, w_down):
    return (jax.nn.silu(h @ w_gate) * (h @ w_up)) @ w_down


def moe_swiglu(h, w_router, w_gate, w_up, w_down):
    logits = (h @ w_router).astype(jnp.float32)
    top_vals, top_idx = lax.top_k(logits, TOP_K)
    top_w = jax.nn.softmax(top_vals, axis=-1)
    gates = jnp.sum(jax.nn.one_hot(top_idx, N_EXPERTS, dtype=jnp.float32) * top_w[..., None], axis=-2)
    gates = gates.astype(h.dtype)
    y = jnp.zeros_like(h)
    for e in range(N_EXPERTS):
        y = y + gates[..., e:e + 1] * swiglu(h, w_gate[e], w_up[e], w_down[e])
    return y


def full_attention(q, k, v):
    s = jnp.einsum('bqhd,bkhd->bhqk', q, k) * (q.shape[-1] ** -0.5)
    p = jax.nn.softmax(s.astype(jnp.float32), axis=-1).astype(v.dtype)
    return jnp.einsum('bhqk,bkhd->bqhd', p, v)


def neighbourhood_tables(rows):
    wr = min(NA_WIN_R, rows)
    nqb = GRID_W // NA_QCOLS
    qcols = np.arange(GRID_W).reshape(nqb, NA_QCOLS)
    kstart = np.clip(NA_QCOLS * np.arange(nqb) - (NA_KCOLS - NA_QCOLS) // 2, 0, GRID_W - NA_KCOLS)
    kcols = kstart[:, None] + np.arange(NA_KCOLS)[None, :]
    wstart = np.clip(qcols - NA_WIN_C // 2, 0, GRID_W - NA_WIN_C)
    kc = kcols[:, None, :]
    mask = (kc >= wstart[..., None]) & (kc < wstart[..., None] + NA_WIN_C)
    mask = np.broadcast_to(mask[:, :, None, :], (nqb, NA_QCOLS, wr, NA_KCOLS)).reshape(nqb, NA_QCOLS, wr * NA_KCOLS)
    dc = np.clip(kc - qcols[..., None], -(NA_WIN_C - 1), NA_WIN_C - 1) + (NA_WIN_C - 1)
    return wr, nqb, kcols, mask, dc


def neighbourhood_attention(h, hc, w_qkv, rpb, w_o, ctx_queries):
    B, S, _ = h.shape
    C = hc.shape[1]
    rows = S // GRID_W
    H, dh = NA_HEADS, NA_HEAD_DIM
    scale = dh ** -0.5
    q, k, v = jnp.split(h @ w_qkv, 3, axis=-1)
    qc, kc, vc = jnp.split(hc @ w_qkv, 3, axis=-1)
    q_grid = q.reshape(B, rows, GRID_W, H, dh)
    k_grid = k.reshape(B, rows, GRID_W, H, dh)
    v_grid = v.reshape(B, rows, GRID_W, H, dh)
    kc = kc.reshape(B, C, H, dh)
    vc = vc.reshape(B, C, H, dh)
    wr, nqb, kcols, mask, dc = neighbourhood_tables(rows)
    n_lat = wr * NA_KCOLS

    def row_step(r):
        rs = jnp.clip(r - wr // 2, 0, rows - wr)
        q_r = lax.dynamic_index_in_dim(q_grid, r, axis=1, keepdims=False).reshape(B, nqb, NA_QCOLS, H, dh)
        k_band = lax.dynamic_slice_in_dim(k_grid, rs, wr, axis=1)[:, :, kcols]
        v_band = lax.dynamic_slice_in_dim(v_grid, rs, wr, axis=1)[:, :, kcols]
        k_blk = jnp.swapaxes(k_band, 1, 2).reshape(B, nqb, n_lat, H, dh)
        v_blk = jnp.swapaxes(v_band, 1, 2).reshape(B, nqb, n_lat, H, dh)
        dr = rs + jnp.arange(wr) - r + (NA_WIN_R - 1)
        bias = jnp.take(rpb[:, dr], dc, axis=2)
        bias = jnp.transpose(bias, (0, 2, 3, 1, 4)).reshape(H, nqb, NA_QCOLS, n_lat)
        s_lat = jnp.einsum('bnqhd,bnkhd->bhnqk', q_r, k_blk) * scale
        s_lat = jnp.where(mask, s_lat.astype(jnp.float32) + bias.astype(jnp.float32), -jnp.inf)
        s_ctx = (jnp.einsum('bnqhd,bkhd->bhnqk', q_r, kc) * scale).astype(jnp.float32)
        p = jax.nn.softmax(jnp.concatenate([s_lat, s_ctx], axis=-1), axis=-1).astype(v.dtype)
        o = (jnp.einsum('bhnqk,bnkhd->bnqhd', p[..., :n_lat], v_blk)
             + jnp.einsum('bhnqk,bkhd->bnqhd', p[..., n_lat:], vc))
        return o.reshape(B, GRID_W, H * dh)

    o = lax.map(row_step, jnp.arange(rows))
    y = jnp.moveaxis(o, 0, 1).reshape(B, S, H * dh) @ w_o
    yc = None
    if ctx_queries:
        oc = full_attention(qc.reshape(B, C, H, dh), kc, vc)
        yc = oc.reshape(B, C, H * dh) @ w_o
    return y, yc


def rope_rotate(x, cos, sin):
    x1, x2 = jnp.split(x, 2, axis=-1)
    return jnp.concatenate([x1 * cos - x2 * sin, x2 * cos + x1 * sin], axis=-1)


def axial_rope(x, rows_pos, cols_pos):
    inv_freq = ROPE_THETA ** (-jnp.arange(0, ROPE_AXIS_DIM, 2, dtype=jnp.float32) / ROPE_AXIS_DIM)
    ang_r = (rows_pos[:, None] * inv_freq)[:, None, None, :]
    ang_c = (cols_pos[:, None] * inv_freq)[:, None, None, :]
    cr, sr = jnp.cos(ang_r).astype(x.dtype), jnp.sin(ang_r).astype(x.dtype)
    cc, sc = jnp.cos(ang_c).astype(x.dtype), jnp.sin(ang_c).astype(x.dtype)
    return jnp.concatenate([rope_rotate(x[..., :ROPE_AXIS_DIM], cr, sr),
                            rope_rotate(x[..., ROPE_AXIS_DIM:], cc, sc)], axis=-1)


def diff_attend(q, k, v, lam):
    s = jnp.einsum('bqhmd,bkhmd->bhmqk', q, k) * (DIFF_HEAD_DIM ** -0.5)
    p = jax.nn.softmax(s.astype(jnp.float32), axis=-1)
    a = (p[:, :, 0] - lam * p[:, :, 1]).astype(v.dtype)
    return jnp.einsum('bhqk,bkhe->bqhe', a, v)


def head_rmsnorm(o, g):
    o32 = o.astype(jnp.float32)
    y = o32 * lax.rsqrt(jnp.mean(o32 * o32, axis=-1, keepdims=True) + NORM_EPS)
    return y.astype(o.dtype) * g


def diff_attention(h, hc, layer_idx, w_qkv, lq1, lk1, lq2, lk2, subln, w_o, ctx_queries):
    B, S, _ = h.shape
    C = hc.shape[1]
    H, dh, E = DIFF_HEADS, DIFF_HEAD_DIM, DIFF_V_DIM
    lam_init = 0.8 - 0.6 * math.exp(-0.3 * layer_idx)
    lam = (jnp.exp(jnp.sum(lq1.astype(jnp.float32) * lk1.astype(jnp.float32)))
           - jnp.exp(jnp.sum(lq2.astype(jnp.float32) * lk2.astype(jnp.float32))) + lam_init)
    q, k, v = jnp.split(h @ w_qkv, 3, axis=-1)
    qc, kc, vc = jnp.split(hc @ w_qkv, 3, axis=-1)
    q = q.reshape(B, S, H, 2, dh)
    k = k.reshape(B, S, H, 2, dh)
    v = v.reshape(B, S, H, E)
    kc = kc.reshape(B, C, H, 2, dh)
    vc = vc.reshape(B, C, H, E)
    pos = jnp.arange(S)
    rows_pos = (pos // GRID_W).astype(jnp.float32)
    cols_pos = (pos % GRID_W).astype(jnp.float32)
    q = axial_rope(q, rows_pos, cols_pos)
    k = axial_rope(k, rows_pos, cols_pos)
    k_all = jnp.concatenate([k, kc], axis=1)
    v_all = jnp.concatenate([v, vc], axis=1)
    nb = S // Q_BLOCK
    q_blocks = jnp.moveaxis(q.reshape(B, nb, Q_BLOCK, H, 2, dh), 1, 0)
    o = lax.map(lambda qb: diff_attend(qb, k_all, v_all, lam), q_blocks)
    o = jnp.moveaxis(o, 0, 1).reshape(B, S, H, E)
    y = (head_rmsnorm(o, subln) * (1 - lam_init)).reshape(B, S, H * E) @ w_o
    yc = None
    if ctx_queries:
        oc = diff_attend(qc.reshape(B, C, H, 2, dh), kc, vc, lam)
        yc = (head_rmsnorm(oc, subln) * (1 - lam_init)).reshape(B, C, H * E) @ w_o
    return y, yc


def setup_inputs(seed: int = 0) -> dict:
    key = jax.random.key(seed)
    ks = iter(jax.random.split(key, 40))
    D = D_MODEL

    def nrm(shape, scale):
        return jax.random.normal(next(ks), shape, jnp.float32) * scale

    def gain(n):
        return 1.0 + nrm((n,), 0.01)

    inp = {}
    inp["x"] = nrm((BATCH, SEQ, D), 1.0)
    inp["c"] = nrm((BATCH, D), 1.0)
    inp["ctx"] = nrm((BATCH, CTX_LEN, D), 1.0)
    inp["c_ctx"] = nrm((D,), 1.0)
    inp["l0_w_ada"] = nrm((D, 6 * D), 0.5 * D ** -0.5)
    inp["l0_b_ada"] = nrm((6 * D,), 0.02)
    inp["l0_norm_mix"] = gain(D)
    inp["l0_w_qkv"] = nrm((D, 3 * D), D ** -0.5)
    inp["l0_rpb"] = nrm((NA_HEADS, 2 * NA_WIN_R - 1, 2 * NA_WIN_C - 1), 0.1)
    inp["l0_w_o"] = nrm((D, D), D ** -0.5)
    inp["l0_norm_ffn"] = gain(D)
    inp["l0_w_gate"] = nrm((D, D_FF), D ** -0.5)
    inp["l0_w_up"] = nrm((D, D_FF), D ** -0.5)
    inp["l0_w_down"] = nrm((D_FF, D), D_FF ** -0.5)
    inp["l1_w_ada"] = nrm((D, 6 * D), 0.5 * D ** -0.5)
    inp["l1_b_ada"] = nrm((6 * D,), 0.02)
    inp["l1_norm_mix"] = gain(D)
    inp["l1_w_qkv"] = nrm((D, 3 * D), D ** -0.5)
    inp["l1_lambda_q1"] = nrm((DIFF_HEAD_DIM,), 0.1)
    inp["l1_lambda_k1"] = nrm((DIFF_HEAD_DIM,), 0.1)
    inp["l1_lambda_q2"] = nrm((DIFF_HEAD_DIM,), 0.1)
    inp["l1_lambda_k2"] = nrm((DIFF_HEAD_DIM,), 0.1)
    inp["l1_subln"] = gain(DIFF_V_DIM)
    inp["l1_w_o"] = nrm((D, D), D ** -0.5)
    inp["l1_norm_ffn"] = gain(D)
    inp["l1_w_router"] = nrm((D, N_EXPERTS), D ** -0.5)
    inp["l1_w_gate"] = nrm((N_EXPERTS, D, D_FF_EXPERT), D ** -0.5)
    inp["l1_w_up"] = nrm((N_EXPERTS, D, D_FF_EXPERT), D ** -0.5)
    inp["l1_w_down"] = nrm((N_EXPERTS, D_FF_EXPERT, D), D_FF_EXPERT ** -0.5)
    inp["final_norm"] = gain(D)
    return inp


def reference(x, c, ctx, c_ctx,
              l0_w_ada, l0_b_ada, l0_norm_mix, l0_w_qkv, l0_rpb, l0_w_o,
              l0_norm_ffn, l0_w_gate, l0_w_up, l0_w_down,
              l1_w_ada, l1_b_ada, l1_norm_mix, l1_w_qkv,
              l1_lambda_q1, l1_lambda_k1, l1_lambda_q2, l1_lambda_k2, l1_subln, l1_w_o,
              l1_norm_ffn, l1_w_router, l1_w_gate, l1_w_up, l1_w_down,
              final_norm):
    layers = [
        dict(w_ada=l0_w_ada, b_ada=l0_b_ada, norm_mix=l0_norm_mix, w_qkv=l0_w_qkv, rpb=l0_rpb,
             w_o=l0_w_o, norm_ffn=l0_norm_ffn, w_gate=l0_w_gate, w_up=l0_w_up, w_down=l0_w_down),
        dict(w_ada=l1_w_ada, b_ada=l1_b_ada, norm_mix=l1_norm_mix, w_qkv=l1_w_qkv,
             lq1=l1_lambda_q1, lk1=l1_lambda_k1, lq2=l1_lambda_q2, lk2=l1_lambda_k2, subln=l1_subln,
             w_o=l1_w_o, norm_ffn=l1_norm_ffn, w_router=l1_w_router,
             w_gate=l1_w_gate, w_up=l1_w_up, w_down=l1_w_down),
    ]
    for i in range(DEPTH):
        p = layers[i]
        ctx_needed = i < DEPTH - 1
        sh1, sc1, g1, sh2, sc2, g2 = adaln_params(c[:, None, :], p["w_ada"], p["b_ada"])
        csh1, csc1, cg1, csh2, csc2, cg2 = adaln_params(c_ctx, p["w_ada"], p["b_ada"])
        h = modulate(rmsnorm(x, p["norm_mix"]), sh1, sc1)
        hc = modulate(rmsnorm(ctx, p["norm_mix"]), csh1, csc1)
        if i % N_MIXERS == 0:
            y, yc = neighbourhood_attention(h, hc, p["w_qkv"], p["rpb"], p["w_o"], ctx_needed)
        else:
            y, yc = diff_attention(h, hc, i, p["w_qkv"], p["lq1"], p["lk1"], p["lq2"], p["lk2"],
                                   p["subln"], p["w_o"], ctx_needed)
        x = x + g1 * y
        if i % 2 == 0:
            ffn = lambda t: swiglu(t, p["w_gate"], p["w_up"], p["w_down"])
        else:
            ffn = lambda t: moe_swiglu(t, p["w_router"], p["w_gate"], p["w_up"], p["w_down"])
        x = x + g2 * ffn(modulate(rmsnorm(x, p["norm_ffn"]), sh2, sc2))
        if ctx_needed:
            ctx = ctx + cg1 * yc
            ctx = ctx + cg2 * ffn(modulate(rmsnorm(ctx, p["norm_ffn"]), csh2, csc2))
    return rmsnorm(x, final_norm)
```

```cpp
#include <hip/hip_runtime.h>
#include <cstdio>
#include <cstdint>
#include <cmath>
namespace pg8 {
#define PG8_LAS __attribute__((address_space(3)))
typedef unsigned short bf16_t;
typedef short bf16x8 __attribute__((ext_vector_type(8)));
typedef float f32x4 __attribute__((ext_vector_type(4)));
typedef unsigned u32x4 __attribute__((ext_vector_type(4)));
constexpr int BM = 256, BK = 64, HALF = 128, HTB = HALF * BK * 2  , STAGE_BYTES = 8 * HTB, NXCD = 8, WGM = 8;

__host__ __device__ __forceinline__ int lds_byte(int r, int c) { const int st = (r >> 4) * 2 + (c >> 5), rr = r & 15, cc = c & 31, ob = rr * 64 + cc * 2; return st * 1024 + (ob ^ (((ob >> 9) & 1) << 5)); }
__host__ __device__ __forceinline__ void stage_rc(int b, int& R, int& C) { const int st = b / 1024, sb = b % 1024, swz = sb ^ (((sb >> 9) & 1) << 5); R = (st >> 1) * 16 + swz / 64; C = (st & 1) * 32 + (swz % 64) / 2; }
__host__ __device__ __forceinline__ int perm32(int rho) { const int n = rho >> 4, i = rho & 15; return 8 * (i >> 2) + 4 * n + (i & 3); }

struct Unit { int pm, pn; };
struct Gemm { const bf16_t* A; const bf16_t* Bt; int M, N, K; };

struct StaticOrder {
    int nM, nN, nwg, G, c;
    __host__ __device__ void init(int M, int N, int G_, int c_) { nM = M / BM; nN = N / BM; nwg = nM * nN; G = G_; c = c_; }
    __host__ __device__ bool next(int i, Unit& u) const {
        const long L = (long)i * G + c; if (L >= nwg) return false;
        int wgid = (int)L; { const int q = nwg / NXCD, r = nwg % NXCD, xcd = wgid % NXCD, off = wgid / NXCD; wgid = (xcd < r ? xcd * (q + 1) : r * (q + 1) + (xcd - r) * q) + off; }
        const int nig = WGM * nN, gid = wgid / nig, fm = gid * WGM, gsz = (nM - fm) < WGM ? (nM - fm) : WGM;
        u.pm = fm + ((wgid % nig) % gsz); u.pn = (wgid % nig) / gsz; return true;
    }
    __device__ __forceinline__ void a_ready(const Unit&) const {}
    __device__ __forceinline__ void done(const Unit&) const {}
};

__device__ __forceinline__ unsigned cvt_pk_bf16(float lo, float hi) { unsigned r; asm volatile("v_cvt_pk_bf16_f32 %0, %1, %2" : "=v"(r) : "v"(lo), "v"(hi)); return r; }
typedef float f32x2 __attribute__((ext_vector_type(2)));
constexpr float QSCALE = 0.125f * 1.4426950408889634f;

struct EpiResid {
    static constexpr bool PERM = false, AFTER_DRAIN = false;
    const float* base_lat; const float* base_ctx; float* out_lat; float* out_ctx; const float* gate;
    __device__ __forceinline__ void operator()(const f32x4 (&acc)[2][2][4][2], const Unit& u, int wr, int wc, int fr, int fq) const {
        const bool lat = u.pm < 128;
        const int br = lat ? (u.pm >> 3) : 16;
        const size_t toff = (size_t)(lat ? u.pm : u.pm - 128) * (256 * 1024);
        const float* bs = (lat ? base_lat : base_ctx) + toff; float* os = (lat ? out_lat : out_ctx) + toff;
        const float* gp = gate + br * 6144;
        const int col0 = u.pn * BM + wc * 32 + 4 * fq;
        f32x4 gv[2][2];
#pragma unroll
        for (int bj = 0; bj < 2; ++bj)
#pragma unroll
            for (int n = 0; n < 2; ++n) gv[bj][n] = *(const f32x4*)(gp + col0 + bj * HALF + n * 16);
#pragma unroll
        for (int ai = 0; ai < 2; ++ai)
#pragma unroll
            for (int m = 0; m < 4; ++m) { const size_t off = (size_t)(ai * HALF + wr * 64 + m * 16 + fr) * 1024 + col0;
#pragma unroll
                for (int bj = 0; bj < 2; ++bj)
#pragma unroll
                    for (int n = 0; n < 2; ++n) { const f32x4 b = *(const f32x4*)(bs + off + bj * HALF + n * 16); *(f32x4*)(os + off + bj * HALF + n * 16) = b + gv[bj][n] * acc[ai][bj][m][n]; }
                asm volatile("" ::: "memory"); }
    }
};

__device__ __forceinline__ float silu_mul(float g, float u) { return g * __builtin_amdgcn_rcpf(1.0f + __builtin_amdgcn_exp2f(-1.4426950408889634f * g)) * u; }
struct EpiSwiGLU {
    static constexpr bool PERM = true, AFTER_DRAIN = false;
    bf16_t* O; int ldc; int row_off; const PG8_LAS int* tile_e; int nN;
    __device__ __forceinline__ void operator()(const f32x4 (&acc)[2][2][4][2], const Unit& u, int wr, int wc, int fr, int fq) const {
        int pnl = u.pn; if (tile_e) pnl -= tile_e[u.pm] * nN;
        const int row0 = u.pm * BM + wr * 64 + fr - row_off, col0 = pnl * HALF + wc * 32 + 8 * fq;
#pragma unroll
        for (int ai = 0; ai < 2; ++ai)
#pragma unroll
            for (int m = 0; m < 4; ++m) { bf16_t* rowp = O + (size_t)(row0 + ai * HALF + m * 16) * ldc + col0;
                const f32x4 g0 = acc[ai][0][m][0], g1 = acc[ai][0][m][1], u0 = acc[ai][1][m][0], u1 = acc[ai][1][m][1];
                u32x4 w; w.x = cvt_pk_bf16(silu_mul(g0[0], u0[0]), silu_mul(g0[1], u0[1])); w.y = cvt_pk_bf16(silu_mul(g0[2], u0[2]), silu_mul(g0[3], u0[3]));
                w.z = cvt_pk_bf16(silu_mul(g1[0], u1[0]), silu_mul(g1[1], u1[1])); w.w = cvt_pk_bf16(silu_mul(g1[2], u1[2]), silu_mul(g1[3], u1[3]));
                *(u32x4*)rowp = w; }
    }
};

struct EpiBf16Grp {
    static constexpr bool PERM = true, AFTER_DRAIN = false;
    bf16_t* O; const PG8_LAS int* tile_e; int nN;
    __device__ __forceinline__ void operator()(const f32x4 (&acc)[2][2][4][2], const Unit& u, int wr, int wc, int fr, int fq) const {
        const int pnl = u.pn - tile_e[u.pm] * nN;
        const int row0 = u.pm * BM + wr * 64 + fr, col0 = pnl * BM + wc * 32 + 8 * fq;
#pragma unroll
        for (int ai = 0; ai < 2; ++ai)
#pragma unroll
            for (int m = 0; m < 4; ++m) { bf16_t* rowp = O + (size_t)(row0 + ai * HALF + m * 16) * 1024 + col0;
#pragma unroll
                for (int bj = 0; bj < 2; ++bj) { const f32x4 v0 = acc[ai][bj][m][0], v1 = acc[ai][bj][m][1];
                    u32x4 w; w.x = cvt_pk_bf16(v0[0], v0[1]); w.y = cvt_pk_bf16(v0[2], v0[3]); w.z = cvt_pk_bf16(v1[0], v1[1]); w.w = cvt_pk_bf16(v1[2], v1[3]);
                    *(u32x4*)(rowp + bj * HALF) = w; } }
    }
};

template <bool ROPE> struct EpiQKV {
    static constexpr bool PERM = true, AFTER_DRAIN = false;
    bf16_t* Q; size_t stride; const float* rope;
    __device__ __forceinline__ void operator()(const f32x4 (&acc)[2][2][4][2], const Unit& u, int wr, int wc, int fr, int fq) const {
        const int t = u.pn >> 2, colt = (u.pn & 3) * BM;
        bf16_t* base = Q + (size_t)t * stride;
        const float sc = (t == 0) ? QSCALE : 1.0f;
        const int row0 = u.pm * BM + wr * 64 + fr, col0 = colt + wc * 32 + 8 * fq;
        const bool do_rope = ROPE && t < 2 && u.pm < 128;
#pragma unroll
        for (int ai = 0; ai < 2; ++ai)
#pragma unroll
            for (int m = 0; m < 4; ++m) { const int row = row0 + ai * HALF + m * 16; bf16_t* rowp = base + (size_t)row * 1024 + col0;
                f32x4 cs[4];
                if (do_rope) { const int tok = row & 2047, pos = (wc & 1) ? (tok & 63) : (tok >> 6); const f32x4* cp = (const f32x4*)(rope + (pos * 16 + 8 * (fq & 1)) * 2);
                    cs[0] = cp[0]; cs[1] = cp[1]; cs[2] = cp[2]; cs[3] = cp[3]; }
#pragma unroll
                for (int bj = 0; bj < 2; ++bj) { f32x4 v0 = acc[ai][bj][m][0], v1 = acc[ai][bj][m][1];
                    if (do_rope) {
                        f32x4 p0, p1;
#pragma unroll
                        for (int j = 0; j < 4; ++j) { p0[j] = __shfl_xor(v0[j], 32); p1[j] = __shfl_xor(v1[j], 32); }
                        const float sg = (fq < 2) ? -1.0f : 1.0f;
                        v0[0] = v0[0] * cs[0][0] + sg * p0[0] * cs[0][1]; v0[1] = v0[1] * cs[0][2] + sg * p0[1] * cs[0][3];
                        v0[2] = v0[2] * cs[1][0] + sg * p0[2] * cs[1][1]; v0[3] = v0[3] * cs[1][2] + sg * p0[3] * cs[1][3];
                        v1[0] = v1[0] * cs[2][0] + sg * p1[0] * cs[2][1]; v1[1] = v1[1] * cs[2][2] + sg * p1[1] * cs[2][3];
                        v1[2] = v1[2] * cs[3][0] + sg * p1[2] * cs[3][1]; v1[3] = v1[3] * cs[3][2] + sg * p1[3] * cs[3][3];
                    }
                    v0 = v0 * sc; v1 = v1 * sc;
                    u32x4 w; w.x = cvt_pk_bf16(v0[0], v0[1]); w.y = cvt_pk_bf16(v0[2], v0[3]); w.z = cvt_pk_bf16(v1[0], v1[1]); w.w = cvt_pk_bf16(v1[2], v1[3]);
                    *(u32x4*)(rowp + bj * HALF) = w; } }
    }
};

struct MoeOrder {
    StaticOrder so; int t0, nN; const PG8_LAS int* tile_e;
    __device__ void init(int ntiles, int nN_, int G_, int c_, int t0_, const PG8_LAS int* te) { so.init(ntiles * BM, nN_ * BM, G_, c_); t0 = t0_; nN = nN_; tile_e = te; }
    __device__ bool next(int i, Unit& u) const { if (!so.next(i, u)) return false; u.pm += t0; u.pn += tile_e[u.pm] * nN; return true; }
    __device__ __forceinline__ void a_ready(const Unit&) const {}
    __device__ __forceinline__ void done(const Unit&) const {}
};

template <class Epi, class Sched, bool ALIGN_EPI = false, bool SP2 = false>
__device__ __forceinline__ void gemm_phase(PG8_LAS unsigned char* lds, const Gemm g, const Sched& S, const Epi& E, int tid_in) {
    int tid_l = tid_in; asm volatile("" : "+v"(tid_l));
    const int tid = tid_l, wid = __builtin_amdgcn_readfirstlane(tid >> 6), lane = tid & 63, wr = wid >> 2, wc = wid & 3, fr = lane & 15, fq = lane >> 4;
    const int K = g.K, nt = K / BK;
    unsigned voffA[2], voffB[2];
#pragma unroll
    for (int i = 0; i < 2; ++i) { int R, C; stage_rc(tid * 16 + i * 8192, R, C); const int Rb = Epi::PERM ? ((R & ~31) + perm32(R & 31)) : R;
        voffA[i] = (unsigned)(R * K + C) * 2u; voffB[i] = (unsigned)(Rb * K + C) * 2u; }
    const size_t kstep = (size_t)(BK * 2);
    const size_t hstep = (size_t)HALF * K * 2;
    const size_t tstep = 2 * hstep;
    const unsigned ldsw = (unsigned)wid * 1024u;
    const int aoff = lds_byte(wr * 64 + fr, fq * 8), boff = lds_byte(wc * 32 + fr, fq * 8);
#define PG8_SA(b, h) (((b) * 2 + (h)) * HTB)
#define PG8_SB(b, h) ((4 + (b) * 2 + (h)) * HTB)
#define PG8_STAGE(bufoff, gbase, voff) do { _Pragma("unroll") for (int _i = 0; _i < 2; ++_i) \
        __builtin_amdgcn_global_load_lds((const unsigned*)((const char*)(gbase) + (voff)[_i]), (PG8_LAS unsigned*)(lds + (bufoff) + ldsw + _i * 8192), 16, 0, 0); } while (0)
#define PG8_LDA(dst, b, h) do { _Pragma("unroll") for (int m = 0; m < 4; ++m) _Pragma("unroll") for (int k = 0; k < 2; ++k) dst[m][k] = *(const PG8_LAS bf16x8*)(lds + PG8_SA(b, h) + aoff + m * 2048 + k * 1024); } while (0)
#define PG8_LDB(dst, b, h) do { _Pragma("unroll") for (int n = 0; n < 2; ++n) _Pragma("unroll") for (int k = 0; k < 2; ++k) dst[n][k] = *(const PG8_LAS bf16x8*)(lds + PG8_SB(b, h) + boff + n * 2048 + k * 1024); } while (0)
#define PG8_MMA(ai, bj, At, Bt) do { __builtin_amdgcn_s_setprio(1); _Pragma("unroll") for (int m = 0; m < 4; ++m) _Pragma("unroll") for (int n = 0; n < 2; ++n) _Pragma("unroll") for (int k = 0; k < 2; ++k) \
        acc[ai][bj][m][n] = __builtin_amdgcn_mfma_f32_16x16x32_bf16(Bt[n][k], At[m][k], acc[ai][bj][m][n], 0, 0, 0); __builtin_amdgcn_s_setprio(0); } while (0)
#define PG8_WAIT_V(n) asm volatile("s_waitcnt vmcnt(" #n ")" ::: "memory")
#define PG8_WAIT_L(n) asm volatile("s_waitcnt lgkmcnt(" #n ")" ::: "memory")
#define PG8_BAR __builtin_amdgcn_s_barrier()
#define PG8_SCHED __builtin_amdgcn_sched_barrier(0)
    Unit cur, nxt; int ui = 0;
    if (!S.next(0, cur)) return;
    f32x4 acc[2][2][4][2];
#pragma unroll
    for (int a = 0; a < 2; ++a)
#pragma unroll
        for (int b = 0; b < 2; ++b)
#pragma unroll
            for (int m = 0; m < 4; ++m)
#pragma unroll
                for (int n = 0; n < 2; ++n) acc[a][b][m][n] = (f32x4){0.f, 0.f, 0.f, 0.f};
    bf16x8 At[4][2], B0[2][2], B1[2][2];
    const char* cA = (const char*)g.A + (size_t)cur.pm * tstep; const char* cB = (const char*)g.Bt + (size_t)cur.pn * tstep;
    S.a_ready(cur);
    if constexpr (SP2) {
        PG8_STAGE(PG8_SB(0, 0), cB, voffB); PG8_STAGE(PG8_SB(0, 1), cB + hstep, voffB); PG8_STAGE(PG8_SA(0, 0), cA, voffA); PG8_STAGE(PG8_SA(0, 1), cA + hstep, voffA);
        if (wr == 1) PG8_BAR;
        PG8_WAIT_V(2); PG8_BAR;
        PG8_STAGE(PG8_SB(1, 0), cB + kstep, voffB); PG8_STAGE(PG8_SA(1, 0), cA + kstep, voffA); PG8_STAGE(PG8_SB(1, 1), cB + hstep + kstep, voffB);
        PG8_WAIT_V(6); PG8_BAR;
    } else {
        PG8_STAGE(PG8_SB(0, 0), cB, voffB); PG8_STAGE(PG8_SA(0, 0), cA, voffA); PG8_STAGE(PG8_SB(0, 1), cB + hstep, voffB); PG8_STAGE(PG8_SA(0, 1), cA + hstep, voffA);
        if (wr == 1) PG8_BAR;
        PG8_WAIT_V(4); PG8_BAR;
        PG8_STAGE(PG8_SB(1, 0), cB + kstep, voffB); PG8_STAGE(PG8_SA(1, 0), cA + kstep, voffA); PG8_STAGE(PG8_SB(1, 1), cB + hstep + kstep, voffB);
        PG8_WAIT_V(6); PG8_BAR;
    }
    for (;;) {
        const bool has_next = S.next(ui + 1, nxt);
        const char* nA = has_next ? (const char*)g.A + (size_t)nxt.pm * tstep : cA; const char* nB = has_next ? (const char*)g.Bt + (size_t)nxt.pn * tstep : cB;
        for (int t = 0; t < nt; t += 2) {
            const bool last = (t == nt - 2);
            const char* a1 = cA + (size_t)(t + 1) * kstep;
            const char* a2 = last ? nA : cA + (size_t)(t + 2) * kstep; const char* b2 = last ? nB : cB + (size_t)(t + 2) * kstep;
            const char* a3 = a2 + kstep; const char* b3 = b2 + kstep;
            if (last && has_next) S.a_ready(nxt);
            if constexpr (SP2) {
            PG8_LDB(B0, 0, 0); PG8_LDB(B1, 0, 1); PG8_SCHED; PG8_LDA(At, 0, 0); PG8_STAGE(PG8_SA(1, 1), a1 + hstep, voffA);
            PG8_WAIT_V(8); PG8_WAIT_L(0); PG8_BAR; PG8_MMA(0, 0, At, B0); PG8_MMA(0, 1, At, B1); PG8_BAR; PG8_SCHED;
            PG8_LDA(At, 0, 1); PG8_STAGE(PG8_SB(0, 0), b2, voffB); PG8_STAGE(PG8_SB(0, 1), b2 + hstep, voffB); PG8_STAGE(PG8_SA(0, 0), a2, voffA);
            PG8_WAIT_V(8); PG8_WAIT_L(0); PG8_BAR; PG8_MMA(1, 0, At, B0); PG8_MMA(1, 1, At, B1); PG8_BAR; PG8_SCHED;
            PG8_LDB(B0, 1, 0); PG8_LDB(B1, 1, 1); PG8_SCHED; PG8_LDA(At, 1, 0); PG8_STAGE(PG8_SA(0, 1), a2 + hstep, voffA);
            PG8_WAIT_V(8); PG8_WAIT_L(0); PG8_BAR; PG8_MMA(0, 0, At, B0); PG8_MMA(0, 1, At, B1); PG8_BAR; PG8_SCHED;
            PG8_LDA(At, 1, 1); PG8_STAGE(PG8_SB(1, 0), b3, voffB); PG8_STAGE(PG8_SB(1, 1), b3 + hstep, voffB); PG8_STAGE(PG8_SA(1, 0), a3, voffA);
            PG8_WAIT_V(8); PG8_WAIT_L(0); PG8_BAR; PG8_MMA(1, 0, At, B0); PG8_MMA(1, 1, At, B1); PG8_BAR; PG8_SCHED;
            } else {
            PG8_LDB(B0, 0, 0); PG8_SCHED; PG8_LDA(At, 0, 0); PG8_STAGE(PG8_SA(1, 1), a1 + hstep, voffA);
            PG8_WAIT_L(8); PG8_BAR; PG8_WAIT_L(0); PG8_MMA(0, 0, At, B0); PG8_BAR; PG8_SCHED;
            PG8_LDB(B1, 0, 1); PG8_STAGE(PG8_SB(0, 0), b2, voffB);
            PG8_BAR; PG8_WAIT_L(0); PG8_MMA(0, 1, At, B1); PG8_BAR;
            PG8_LDA(At, 0, 1); PG8_STAGE(PG8_SA(0, 0), a2, voffA);
            PG8_BAR; PG8_WAIT_L(0); PG8_MMA(1, 0, At, B0); PG8_BAR; PG8_SCHED;
            PG8_STAGE(PG8_SB(0, 1), b2 + hstep, voffB);
            PG8_WAIT_V(6); PG8_BAR; PG8_MMA(1, 1, At, B1); PG8_BAR;
            PG8_LDB(B0, 1, 0); PG8_SCHED; PG8_LDA(At, 1, 0); PG8_STAGE(PG8_SA(0, 1), a2 + hstep, voffA);
            PG8_WAIT_L(8); PG8_BAR; PG8_WAIT_L(0); PG8_MMA(0, 0, At, B0); PG8_BAR; PG8_SCHED;
            PG8_LDB(B1, 1, 1); PG8_STAGE(PG8_SB(1, 0), b3, voffB);
            PG8_BAR; PG8_WAIT_L(0); PG8_MMA(0, 1, At, B1); PG8_BAR;
            PG8_LDA(At, 1, 1); PG8_STAGE(PG8_SA(1, 0), a3, voffA);
            PG8_BAR; PG8_WAIT_L(0); PG8_MMA(1, 0, At, B0); PG8_BAR; PG8_SCHED;
            PG8_STAGE(PG8_SB(1, 1), b3 + hstep, voffB);
            PG8_WAIT_V(6); PG8_BAR; PG8_MMA(1, 1, At, B1); PG8_BAR;
            }
        }
        if constexpr (ALIGN_EPI) { if (wr == 0) PG8_BAR; }
        if constexpr (!Epi::AFTER_DRAIN) { E(acc, cur, wr, wc, fr, fq); S.done(cur); }
        if (!has_next) break;
#pragma unroll
        for (int a = 0; a < 2; ++a)
#pragma unroll
            for (int b = 0; b < 2; ++b)
#pragma unroll
                for (int m = 0; m < 4; ++m)
#pragma unroll
                    for (int n = 0; n < 2; ++n) acc[a][b][m][n] = (f32x4){0.f, 0.f, 0.f, 0.f};
        cur = nxt; cA = nA; cB = nB; ++ui;
        if constexpr (ALIGN_EPI) { if (wr == 1) PG8_BAR; }
    }
    PG8_WAIT_V(0);
    if constexpr (!ALIGN_EPI) { if (wr == 0) PG8_BAR; }
    PG8_BAR;
    if constexpr (Epi::AFTER_DRAIN) { E.fused(acc, cur, wr, wc, fr, fq, lds, wid, lane); S.done(cur); }
#undef PG8_SA
#undef PG8_SB
#undef PG8_STAGE
#undef PG8_LDA
#undef PG8_LDB
#undef PG8_MMA
#undef PG8_WAIT_V
#undef PG8_WAIT_L
#undef PG8_BAR
#undef PG8_SCHED
}
}
namespace att {
#define ATT_LAS __attribute__((address_space(3)))
typedef float f32x16 __attribute__((ext_vector_type(16)));
typedef float f32x4 __attribute__((ext_vector_type(4)));
typedef short bf16x8 __attribute__((ext_vector_type(8)));
typedef short s16x4 __attribute__((ext_vector_type(4)));
typedef short v4i16_t __attribute__((ext_vector_type(4)));
typedef unsigned u32x4 __attribute__((ext_vector_type(4)));
typedef unsigned short bf16_t;
constexpr int PITCH = 1024;
constexpr float LOG2E = 1.4426950408889634f;
constexpr int L_K = 0, L_V = 32768, L_WSF = 65536, L_RPB = 65536 + 8 * 512, L_QST = 65536 + 8192, KBUF = 16384, VBUF = 16384;

__device__ __forceinline__ int crow(int r, int hi) { return (r & 3) + 8 * (r >> 2) + 4 * hi; }
__device__ __forceinline__ s16x4 vtr(const ATT_LAS char* p) { return __builtin_bit_cast(s16x4, __builtin_amdgcn_ds_read_tr16_b64_v4i16((ATT_LAS v4i16_t*)p)); }
__device__ __forceinline__ unsigned cvtpk(float lo, float hi) { unsigned r; asm volatile("v_cvt_pk_bf16_f32 %0, %1, %2" : "=v"(r) : "v"(lo), "v"(hi)); return r; }
__device__ __forceinline__ unsigned f2bf(float f) { unsigned u = __builtin_bit_cast(unsigned, f); return (u + 0x7fffu + ((u >> 16) & 1u)) >> 16; }
__device__ __forceinline__ void dma16(const void* g, ATT_LAS unsigned char* l) { __builtin_amdgcn_global_load_lds((const unsigned*)g, (ATT_LAS unsigned*)l, 16, 0, 0); }
#define ATT_LDSW() asm volatile("s_waitcnt lgkmcnt(0)" ::: "memory")

struct NoMask { __device__ __forceinline__ void operator()(f32x16&, f32x16&) const {} };
struct NaMask {
    const ATT_LAS float* brow; int c, ws, hi;
    __device__ __forceinline__ void operator()(f32x16& p0, f32x16& p1) const {
#pragma unroll
        for (int r = 0; r < 16; ++r) {
            const int kc0 = crow(r, hi), kc1 = kc0 + 32;
            int i0 = kc0 - c + 15, i1 = kc1 - c + 15; i0 = i0 < 0 ? 0 : (i0 > 30 ? 30 : i0); i1 = i1 < 0 ? 0 : (i1 > 30 ? 30 : i1);
            const float b0 = brow[i0], b1 = brow[i1];
            p0[r] = ((unsigned)(kc0 - ws) < 16u) ? p0[r] + b0 : -INFINITY;
            p1[r] = ((unsigned)(kc1 - ws) < 16u) ? p1[r] + b1 : -INFINITY;
        }
    }
};

template <int NDB, class Mask>
__device__ __forceinline__ void qk_step(const ATT_LAS unsigned char* Kimg, const bf16x8 (&qr)[4], float& m, float& l, f32x16 (&o)[NDB], u32x4 (&pa)[4], ATT_LAS float* wsf, const Mask& mask, int r32, int hi) {
    f32x16 p0, p1;
#pragma unroll
    for (int r = 0; r < 16; ++r) { p0[r] = 0.f; p1[r] = 0.f; }
    const ATT_LAS unsigned char* kb = Kimg + hi * 1024 + r32 * 16;
#pragma unroll
    for (int d0 = 0; d0 < 4; ++d0) {
        const bf16x8 b0 = *(const ATT_LAS bf16x8*)(kb + d0 * 2048);
        const bf16x8 b1 = *(const ATT_LAS bf16x8*)(kb + d0 * 2048 + 512);
        p0 = __builtin_amdgcn_mfma_f32_32x32x16_bf16(b0, qr[d0], p0, 0, 0, 0);
        p1 = __builtin_amdgcn_mfma_f32_32x32x16_bf16(b1, qr[d0], p1, 0, 0, 0);
    }
    mask(p0, p1);
    float mx = fmaxf(p0[0], p1[0]);
#pragma unroll
    for (int r = 1; r < 16; ++r) mx = fmaxf(mx, fmaxf(p0[r], p1[r]));
    mx = fmaxf(mx, __shfl_xor(mx, 32));
    const float mn = fmaxf(m, mx);
    if (__any(mn > m)) {
        const float alpha = __builtin_amdgcn_exp2f(m - mn);
        l *= alpha; m = mn;
        if (hi == 0) wsf[r32] = alpha;
        ATT_LDSW();
#pragma unroll
        for (int g = 0; g < 4; ++g) { const f32x4 a4 = *(const ATT_LAS f32x4*)(wsf + 8 * g + 4 * hi);
#pragma unroll
            for (int db = 0; db < NDB; ++db) { o[db][4 * g] *= a4[0]; o[db][4 * g + 1] *= a4[1]; o[db][4 * g + 2] *= a4[2]; o[db][4 * g + 3] *= a4[3]; } }
        ATT_LDSW();
    }
    float s = 0.f;
#pragma unroll
    for (int r = 0; r < 16; ++r) { p0[r] = __builtin_amdgcn_exp2f(p0[r] - m); p1[r] = __builtin_amdgcn_exp2f(p1[r] - m); s += p0[r] + p1[r]; }
    l += s;
    pa[0] = (u32x4){cvtpk(p0[0], p0[1]), cvtpk(p0[2], p0[3]), cvtpk(p0[4], p0[5]), cvtpk(p0[6], p0[7])};
    pa[1] = (u32x4){cvtpk(p0[8], p0[9]), cvtpk(p0[10], p0[11]), cvtpk(p0[12], p0[13]), cvtpk(p0[14], p0[15])};
    pa[2] = (u32x4){cvtpk(p1[0], p1[1]), cvtpk(p1[2], p1[3]), cvtpk(p1[4], p1[5]), cvtpk(p1[6], p1[7])};
    pa[3] = (u32x4){cvtpk(p1[8], p1[9]), cvtpk(p1[10], p1[11]), cvtpk(p1[12], p1[13]), cvtpk(p1[14], p1[15])};
}
__device__ __forceinline__ bf16x8 vfrag(const ATT_LAS unsigned char* p) { const s16x4 lo = vtr((const ATT_LAS char*)p), hi4 = vtr((const ATT_LAS char*)p + 512); return (bf16x8){lo[0], lo[1], lo[2], lo[3], hi4[0], hi4[1], hi4[2], hi4[3]}; }

__device__ __forceinline__ void na_unit(int b, int h, int rg, const bf16_t* Q, const bf16_t* K, const bf16_t* V, bf16_t* O, const float* rpb, ATT_LAS unsigned char* lds, int tid_in) {
    int tid_l = tid_in; asm volatile("" : "+v"(tid_l));
    const int tid = tid_l, lane = tid & 63, r32 = lane & 31, hi = lane >> 5; const int wid = __builtin_amdgcn_readfirstlane(tid >> 6);
    const bool latq = rg < 8;
    int r = 0, c0 = 0, rs = 0, kr_lo = 0, n_lat = 0, qrow;
    if (latq) { r = 4 * rg + (wid >> 1); c0 = 32 * (wid & 1); rs = r - 4; rs = rs < 0 ? 0 : (rs > 24 ? 24 : rs);
        kr_lo = 4 * rg - 4; kr_lo = kr_lo < 0 ? 0 : (kr_lo > 24 ? 24 : kr_lo); int kh = 4 * rg + 3 - 4; kh = kh < 0 ? 0 : (kh > 24 ? 24 : kh); n_lat = kh + 7 - kr_lo + 1;
        qrow = b * 2048 + r * 64 + c0; }
    else qrow = 32768 + b * 256 + wid * 32;
    const int NT = n_lat + 4;
    ATT_LAS float* wsf = (ATT_LAS float*)(lds + L_WSF) + wid * 128;
    ATT_LAS float* rpbL = (ATT_LAS float*)(lds + L_RPB);
    __syncthreads();
    if (latq && tid < 465) rpbL[tid] = rpb[h * 465 + tid] * LOG2E;
    const bf16_t* ksrc = K + (size_t)lane * PITCH + h * 64 + wid * 8;
    const bf16_t* vsrc = V + (size_t)(16 * (wid & 3) + (lane >> 2)) * PITCH + h * 64 + (wid >> 2) * 32 + (lane & 3) * 8;
#define NA_TROW(t) ((t) < n_lat ? b * 2048 + (kr_lo + (t)) * 64 : 32768 + b * 256 + ((t) - n_lat) * 64)
#define NA_DMA(t) do { const size_t ro_ = (size_t)NA_TROW(t) * PITCH; const int bo_ = ((t) & 1); \
        dma16(ksrc + ro_, lds + L_K + bo_ * KBUF + wid * 1024); dma16(vsrc + ro_, lds + L_V + bo_ * VBUF + wid * 1024); } while (0)
    NA_DMA(0);
    bf16x8 qr[4];
#pragma unroll
    for (int d0 = 0; d0 < 4; ++d0) qr[d0] = *(const bf16x8*)(Q + (size_t)(qrow + r32) * PITCH + h * 64 + d0 * 16 + hi * 8);
    float m = -1e30f, l = 0.f; f32x16 o[2];
#pragma unroll
    for (int i = 0; i < 16; ++i) { o[0][i] = 0.f; o[1][i] = 0.f; }
    const int vb = ((lane >> 4) & 1) * 32 + (lane & 3) * 8 + (4 * hi + ((lane & 15) >> 2)) * 64;
    const int c = c0 + r32; int ws = c - 8; ws = ws < 0 ? 0 : (ws > 48 ? 48 : ws);
    for (int t = 0; t < NT; ++t) {
        asm volatile("s_waitcnt vmcnt(0)" ::: "memory");
        __syncthreads();
        if (t + 1 < NT) NA_DMA(t + 1);
        bool mine = true; int kr = 0;
        if (t < n_lat) { kr = kr_lo + t; mine = (kr >= rs) && (kr <= rs + 7); }
        if (mine) {
            const ATT_LAS unsigned char* Kimg = lds + L_K + (t & 1) * KBUF; const ATT_LAS unsigned char* Vimg = lds + L_V + (t & 1) * VBUF;
            u32x4 pa[4];
            if (t < n_lat) { NaMask mk{rpbL + (kr - r + 7) * 31, c, ws, hi}; qk_step<2>(Kimg, qr, m, l, o, pa, wsf, mk, r32, hi); }
            else { NoMask mk; qk_step<2>(Kimg, qr, m, l, o, pa, wsf, mk, r32, hi); }
#pragma unroll
            for (int db = 0; db < 2; ++db)
#pragma unroll
                for (int ks = 0; ks < 4; ++ks) { const bf16x8 vf = vfrag(Vimg + vb + db * 4096 + ks * 1024);
                    o[db] = __builtin_amdgcn_mfma_f32_32x32x16_bf16(__builtin_bit_cast(bf16x8, pa[ks]), vf, o[db], 0, 0, 0); }
        }
    }
#undef NA_DMA
#undef NA_TROW
    l += __shfl_xor(l, 32);
    if (hi == 0) wsf[r32] = 1.0f / l;
    ATT_LDSW();
    bf16_t* Ow = O + (size_t)qrow * PITCH + h * 64;
#pragma unroll
    for (int g = 0; g < 4; ++g) { const f32x4 a4 = *(const ATT_LAS f32x4*)(wsf + 8 * g + 4 * hi);
#pragma unroll
        for (int j = 0; j < 4; ++j) { const int q = 8 * g + 4 * hi + j;
#pragma unroll
            for (int db = 0; db < 2; ++db) Ow[(size_t)q * PITCH + db * 32 + r32] = (bf16_t)f2bf(o[db][4 * g + j] * a4[j]); } }
    ATT_LDSW();
}

__device__ __forceinline__ void diff_unit(int b, int hd, int qb, const bf16_t* Q, const bf16_t* K, const bf16_t* V, bf16_t* O, float lam, float outscale, const float* subln, ATT_LAS unsigned char* lds, int tid_in) {
    int tid_l = tid_in; asm volatile("" : "+v"(tid_l));
    const int tid = tid_l, lane = tid & 63, r32 = lane & 31, hi = lane >> 5; const int wid = __builtin_amdgcn_readfirstlane(tid >> 6);
    const int qrow = b * 2048 + qb * 256 + wid * 32;
    constexpr int NT = 36;
    ATT_LAS float* wsf = (ATT_LAS float*)(lds + L_WSF) + wid * 128;
    __syncthreads();
    const bf16_t* ksrc = K + (size_t)lane * PITCH + hd * 128 + wid * 8;
    const bf16_t* vsrc = V + (size_t)(16 * (wid & 3) + (lane >> 2)) * PITCH + hd * 128 + (wid >> 2) * 32 + (lane & 3) * 8;
#define DF_TROW(t) ((t) < 32 ? b * 2048 + (t) * 64 : 32768 + b * 256 + ((t) - 32) * 64)
#define DF_DMA(t) do { const size_t ro_ = (size_t)DF_TROW(t) * PITCH; const int bo_ = ((t) & 1); \
        dma16(ksrc + ro_, lds + L_K + bo_ * KBUF + wid * 1024); dma16(ksrc + ro_ + 64, lds + L_K + bo_ * KBUF + (wid + 8) * 1024); \
        dma16(vsrc + ro_, lds + L_V + bo_ * VBUF + wid * 1024); dma16(vsrc + ro_ + 64, lds + L_V + bo_ * VBUF + (wid + 8) * 1024); } while (0)
    DF_DMA(0);
    ATT_LAS unsigned char* qst = lds + L_QST + wid * 8192;
#pragma unroll
    for (int d0 = 0; d0 < 8; ++d0) *(ATT_LAS bf16x8*)(qst + d0 * 1024 + lane * 16) = *(const bf16x8*)(Q + (size_t)(qrow + r32) * PITCH + hd * 128 + d0 * 16 + hi * 8);
    float m1 = -1e30f, l1 = 0.f, m2 = -1e30f, l2 = 0.f; f32x16 o1[4], o2[4];
#pragma unroll
    for (int db = 0; db < 4; ++db)
#pragma unroll
        for (int i = 0; i < 16; ++i) { o1[db][i] = 0.f; o2[db][i] = 0.f; }
    const int vb = ((lane >> 4) & 1) * 32 + (lane & 3) * 8 + (4 * hi + ((lane & 15) >> 2)) * 64;
    for (int t = 0; t < NT; ++t) {
        asm volatile("s_waitcnt vmcnt(0)" ::: "memory");
        __syncthreads();
        if (t + 1 < NT) DF_DMA(t + 1);
        const ATT_LAS unsigned char* Kimg = lds + L_K + (t & 1) * KBUF; const ATT_LAS unsigned char* Vimg = lds + L_V + (t & 1) * VBUF;
        u32x4 pa1[4], pa2[4]; NoMask mk;
        { bf16x8 qf[4];
#pragma unroll
          for (int d0 = 0; d0 < 4; ++d0) qf[d0] = *(const ATT_LAS bf16x8*)(qst + d0 * 1024 + lane * 16);
          qk_step<4>(Kimg, qf, m1, l1, o1, pa1, wsf, mk, r32, hi); }
        { bf16x8 qf[4];
#pragma unroll
          for (int d0 = 0; d0 < 4; ++d0) qf[d0] = *(const ATT_LAS bf16x8*)(qst + (4 + d0) * 1024 + lane * 16);
          qk_step<4>(Kimg + 8192, qf, m2, l2, o2, pa2, wsf, mk, r32, hi); }
#pragma unroll
        for (int db = 0; db < 4; ++db)
#pragma unroll
            for (int ks = 0; ks < 4; ++ks) { const bf16x8 vf = vfrag(Vimg + vb + db * 4096 + ks * 1024);
                o1[db] = __builtin_amdgcn_mfma_f32_32x32x16_bf16(__builtin_bit_cast(bf16x8, pa1[ks]), vf, o1[db], 0, 0, 0);
                o2[db] = __builtin_amdgcn_mfma_f32_32x32x16_bf16(__builtin_bit_cast(bf16x8, pa2[ks]), vf, o2[db], 0, 0, 0); }
    }
#undef DF_DMA
#undef DF_TROW
    l1 += __shfl_xor(l1, 32); l2 += __shfl_xor(l2, 32);
    if (hi == 0) { wsf[r32] = 1.0f / l1; wsf[32 + r32] = lam / l2; }
    ATT_LDSW();
    float gn[4];
#pragma unroll
    for (int db = 0; db < 4; ++db) gn[db] = subln[db * 32 + r32] * outscale;
    bf16_t* Ow = O + (size_t)qrow * PITCH + hd * 128;
#pragma unroll
    for (int g = 0; g < 4; ++g) { const f32x4 a4 = *(const ATT_LAS f32x4*)(wsf + 8 * g + 4 * hi); const f32x4 b4 = *(const ATT_LAS f32x4*)(wsf + 32 + 8 * g + 4 * hi);
#pragma unroll
        for (int j = 0; j < 4; ++j) { const int q = 8 * g + 4 * hi + j; float v[4]; float ss = 0.f;
#pragma unroll
            for (int db = 0; db < 4; ++db) { v[db] = o1[db][4 * g + j] * a4[j] - o2[db][4 * g + j] * b4[j]; ss += v[db] * v[db]; }
            ss += __shfl_xor(ss, 1); ss += __shfl_xor(ss, 2); ss += __shfl_xor(ss, 4); ss += __shfl_xor(ss, 8); ss += __shfl_xor(ss, 16);
            const float rn = 1.0f / sqrtf(ss * (1.0f / 128.0f) + 1e-6f);
#pragma unroll
            for (int db = 0; db < 4; ++db) Ow[(size_t)q * PITCH + db * 32 + r32] = (bf16_t)f2bf(v[db] * rn * gn[db]); } }
    ATT_LDSW();
}
}

#define GAS __attribute__((address_space(1)))
#define LAS __attribute__((address_space(3)))
typedef unsigned short bf16;
typedef unsigned v4u __attribute__((ext_vector_type(4)));
typedef float f32x4 __attribute__((ext_vector_type(4)));
typedef short bf16x8 __attribute__((ext_vector_type(8)));
typedef GAS unsigned gu32;
typedef GAS unsigned long long gu64;
#define RLX_AGENT __ATOMIC_RELAXED, __HIP_MEMORY_SCOPE_AGENT
#define LDS_WAIT() asm volatile("s_waitcnt lgkmcnt(0)" ::: "memory")
#define VM_WAIT() asm volatile("s_waitcnt vmcnt(0)" ::: "memory")
__device__ __forceinline__ unsigned long long rt() { return __builtin_amdgcn_s_memrealtime(); }
__device__ __forceinline__ unsigned f2bf(float f) { unsigned u = __builtin_bit_cast(unsigned, f); return (u + 0x7fffu + ((u >> 16) & 1u)) >> 16; }
__device__ __forceinline__ unsigned pk2(float lo, float hi) { return f2bf(lo) | (f2bf(hi) << 16); }

#define XB_TMO      128
#define XB_XCNT(j)  (256  + 64 * (j))
#define XB_XSUB(j)  (1280 + 64 * (j))
#define XB_XGEN(j)  (2304 + 64 * (j))
#define XB_TOP      3328
#define XB_TOPGEN   3392
#define XCD_BAR_WORDS 3456
#define XB_SPIN_CAP (1u << 18)

__device__ __forceinline__ unsigned xb_ld(unsigned* p)              { return __hip_atomic_load(p, __ATOMIC_RELAXED, __HIP_MEMORY_SCOPE_AGENT); }
__device__ __forceinline__ unsigned xb_add(unsigned* p, unsigned v) { return __hip_atomic_fetch_add(p, v, __ATOMIC_RELAXED, __HIP_MEMORY_SCOPE_AGENT); }
__device__ __forceinline__ unsigned xb_xcc_id() { return (unsigned)__builtin_amdgcn_s_getreg((3 << 11) | 20) & 0xFu; }
#define XB_SPIN(cond, bar) do { unsigned _sp = 0; while (cond) { __builtin_amdgcn_s_sleep(1); \
    if ((++_sp & 255u) == 0u) { if (xb_ld(&(bar)[XB_TMO])) break; if (_sp > XB_SPIN_CAP) { atomicAdd(&(bar)[XB_TMO], 1u); break; } } } } while (0)

struct XcdBarrier {
    unsigned* bar; unsigned x;
    volatile LAS unsigned* st;
};

__device__ __forceinline__ XcdBarrier xcd_barrier_post(unsigned* bar, volatile LAS unsigned* st) {
    XcdBarrier b; b.bar = bar; b.x = xb_xcc_id(); b.st = st;
    if (threadIdx.x == 0) (void)xb_add(&bar[XB_XCNT(b.x)], 1u);
    return b;
}
__device__ __forceinline__ void xcd_barrier_complete(unsigned* bar, unsigned x, unsigned& nloc, unsigned& nx) {
    const unsigned G = gridDim.x * gridDim.y * gridDim.z;
    unsigned sum, cnt, mine, sp = 0u;
    for (;;) {
        sum = 0u; cnt = 0u; mine = 0u;
#pragma unroll
        for (unsigned j = 0; j < 16; ++j) { const unsigned c = xb_ld(&bar[XB_XCNT(j)]); sum += c; cnt += (c > 0u) ? 1u : 0u; mine = (j == x) ? c : mine; }
        if (sum == G) break;
        __builtin_amdgcn_s_sleep(1);
        if ((++sp & 255u) == 0u) { if (xb_ld(&bar[XB_TMO])) break; if (sp > XB_SPIN_CAP) { atomicAdd(&bar[XB_TMO], 1u); break; } }
    }
    nloc = mine > 0u ? mine : 1u; nx = cnt > 0u ? cnt : 1u;
}

__device__ __forceinline__ void xcd_barrier(const XcdBarrier& b) {
    asm volatile("s_waitcnt vmcnt(0)" ::: "memory");
    __syncthreads();
    if (threadIdx.x == 0) {
        unsigned* bar = b.bar;
        __builtin_amdgcn_s_waitcnt(0);
        unsigned nloc = b.st[0], nx = b.st[1];
        if (nloc == 0u) { xcd_barrier_complete(bar, b.x, nloc, nx); b.st[0] = nloc; b.st[1] = nx; }
        const unsigned old = xb_add(&bar[XB_XSUB(b.x)], 1u);
        const unsigned gen = old / nloc;
        if (old + 1u == (gen + 1u) * nloc) {
            __builtin_amdgcn_fence(__ATOMIC_RELEASE, "agent");
            asm volatile("s_waitcnt vmcnt(0)" ::: "memory");
            const unsigned og = xb_add(&bar[XB_TOP], 1u);
            const unsigned tg = og / nx;
            if (og + 1u == (tg + 1u) * nx) xb_add(&bar[XB_TOPGEN], 1u);
            else XB_SPIN(xb_ld(&bar[XB_TOPGEN]) == tg, bar);
            __builtin_amdgcn_fence(__ATOMIC_ACQUIRE, "agent");
            xb_add(&bar[XB_XGEN(b.x)], 1u);
            asm volatile("s_waitcnt vmcnt(0)" ::: "memory");
        } else {
            XB_SPIN(xb_ld(&bar[XB_XGEN(b.x)]) == gen, bar);
            __builtin_amdgcn_fence(__ATOMIC_ACQUIRE, "agent");
            asm volatile("s_waitcnt vmcnt(0)" ::: "memory");
        }
    }
    __syncthreads();
}
namespace cfg {
constexpr int D = 1024, NB = 16, SEQ = 2048, CTXL = 256;
constexpr int ML = NB * SEQ, MC = NB * CTXL, MT = ML + MC;
constexpr int DFF = 2816, NE = 8, DFE = 3584, MODW = 6 * D;
constexpr int MOE_TILES_MAX = 264, MOE_CHUNK = 132;
constexpr float EPS = 1e-6f, LOG2E = 1.4426950408889634f;
constexpr float LAM_INIT = 0.35550906759096925f;
}
using namespace cfg;
constexpr int NWAVES = 8;
constexpr size_t MiB = 1u << 20;
constexpr size_t WS_CTL = 0, CTL_ZERO_BYTES = 1 * MiB;
constexpr size_t WS_MOD = 1 * MiB;
constexpr size_t WS_ROPE = 2 * MiB;
constexpr size_t WS_TOKE = 3 * MiB, WS_TOKW = WS_TOKE + 256 * 1024, WS_TOKP = WS_TOKW + 256 * 1024, WS_TOKS = WS_TOKP + 256 * 1024;
constexpr size_t WS_W0QKV = 8 * MiB, WS_W0O = 14 * MiB, WS_W0GU = 16 * MiB, WS_W0D = 27 * MiB, WS_W1QKV = 33 * MiB, WS_W1O = 39 * MiB, WS_WMGU = 42 * MiB, WS_WMD = 154 * MiB;
constexpr size_t WS_R = 210 * MiB;
constexpr size_t WS_H = WS_R, WS_Q = WS_R + 72 * MiB, WS_K = WS_R + 144 * MiB, WS_V = WS_R + 216 * MiB, WS_XCTX = WS_R + 288 * MiB;
constexpr size_t WS_ACT0 = WS_Q;
constexpr size_t WS_APERM = WS_R, WS_H2 = WS_K, WS_ACT1 = WS_R + 132 * MiB, WS_END = WS_ACT1 + 231 * MiB;
static_assert(WS_WMD + (size_t)NE * D * DFE * 2 <= WS_R && WS_ACT0 + (size_t)MT * DFF * 2 <= WS_XCTX && WS_H2 >= WS_APERM + (size_t)MOE_TILES_MAX * 256 * D * 2 && WS_END <= 593 * MiB, "d_ws map");
constexpr int CW_CNT = 1024;
constexpr int CW_BAR = 4096;
constexpr int RING_OFF = 0, RING_BYTES = 139264;
constexpr int LDSCTL_OFF = RING_BYTES, MISC_OFF = LDSCTL_OFF + 320;
constexpr int TILE_E_OFF = MISC_OFF + 128;
constexpr int EBASE_OFF = TILE_E_OFF + 272 * 4;
constexpr int LDS_BYTES = 147456;
static_assert(EBASE_OFF + 128 <= LDS_BYTES, "LDS map");

__device__ __forceinline__ float wave_sum(float v) {
#pragma unroll
    for (int o = 1; o < 64; o <<= 1) v += __shfl_xor(v, o);
    return v;
}
__device__ __forceinline__ void transpose_item(const float* W, int K, int N, bf16* WT, int k0, int n0, int drow0, LAS float* scr, int lane) {
#pragma unroll 8
    for (int i = 0; i < 32; ++i) { const int kk = 2 * i + (lane >> 5); scr[kk * 33 + (lane & 31)] = W[(size_t)(k0 + kk) * N + n0 + (lane & 31)]; }
    LDS_WAIT(); asm volatile("" ::: "memory");
    const int c = lane & 7;
#pragma unroll
    for (int j = 0; j < 4; ++j) { const int n = (lane >> 3) + 8 * j; const LAS float* s = scr + (8 * c) * 33 + n;
        v4u o; o.x = pk2(s[0 * 33], s[1 * 33]); o.y = pk2(s[2 * 33], s[3 * 33]); o.z = pk2(s[4 * 33], s[5 * 33]); o.w = pk2(s[6 * 33], s[7 * 33]);
        *(GAS v4u*)(WT + (size_t)(drow0 + n) * K + k0 + 8 * c) = o; }
    LDS_WAIT(); asm volatile("" ::: "memory");
}
struct CvtMat { const float* src; bf16* dst; int K, N, mode, nmat; };
__device__ __forceinline__ void cvt_run(const CvtMat& cm, int it, LAS float* scr, int lane) {
    const int nblk = cm.N / 32, per = (cm.K / 64) * nblk;
    const int e = it / per, r = it % per, kb = r / nblk, nb = r % nblk, n0 = nb * 32;
    const int drow0 = (cm.mode == 0) ? n0 : ((n0 >> 7) * 256 + (n0 & 127) + (cm.mode == 2 ? 128 : 0));
    const int rows_per = (cm.mode == 0) ? cm.N : 2 * cm.N;
    transpose_item(cm.src + (size_t)e * cm.K * cm.N, cm.K, cm.N, cm.dst + (size_t)e * rows_per * cm.K, kb * 64, n0, drow0, scr, lane);
}
__device__ __forceinline__ void norm_mod_row(const float* xrow, const float* gain, const float* shift, const float* scale, bf16* orow, int lane, f32x4 (&v)[4]) {
    const GAS f32x4* xr = (const GAS f32x4*)xrow + lane; float s2 = 0.f;
#pragma unroll
    for (int j = 0; j < 4; ++j) { v[j] = xr[64 * j]; s2 += (v[j].x * v[j].x + v[j].y * v[j].y) + (v[j].z * v[j].z + v[j].w * v[j].w); }
    const float rstd = 1.0f / sqrtf(wave_sum(s2) * (1.f / D) + EPS);
    GAS unsigned long long* o8 = (GAS unsigned long long*)orow + lane;
#pragma unroll
    for (int j = 0; j < 4; ++j) { const f32x4 g = ((const f32x4*)gain)[lane + 64 * j], sh = ((const f32x4*)shift)[lane + 64 * j], sc = ((const f32x4*)scale)[lane + 64 * j];
        v[j] = (v[j] * rstd * g) * (sc + 1.0f) + sh;
        o8[64 * j] = (unsigned long long)pk2(v[j].x, v[j].y) | ((unsigned long long)pk2(v[j].z, v[j].w) << 32); }
}

struct Args { const float* in[30]; float* out; unsigned char* ws; };
__global__ void __launch_bounds__(NWAVES * 64, 2) mega_fwd(Args args) {
    extern __shared__ __attribute__((aligned(16))) unsigned char lds_raw[];
    LAS unsigned char* lds = (LAS unsigned char*)lds_raw;
    volatile LAS unsigned* MISC = (volatile LAS unsigned*)(lds + MISC_OFF);
    LAS int* tile_e = (LAS int*)(lds + TILE_E_OFF);
    LAS int* ebase = (LAS int*)(lds + EBASE_OFF);
    const int G = gridDim.x, bx = blockIdx.x, vcu = (G % 8 == 0) ? (bx % 8) * (G / 8) + bx / 8 : bx;
    const int NGW = G * NWAVES;
    const int wave = __builtin_amdgcn_readfirstlane(threadIdx.x >> 6);
#define PHASE_IDS() int lane_l; asm volatile("v_mbcnt_lo_u32_b32 %0, -1, 0\n\tv_mbcnt_hi_u32_b32 %0, -1, %0" : "=v"(lane_l)); const int lane = lane_l, tid = wave * 64 + lane, gw = vcu * NWAVES + wave; (void)gw
#define x_in (args.in[0])
#define c_in (args.in[1])
#define ctx_in (args.in[2])
#define cctx_in (args.in[3])
#define l0_wada (args.in[4])
#define l0_bada (args.in[5])
#define l0_nmix (args.in[6])
#define l0_wqkv (args.in[7])
#define l0_rpb (args.in[8])
#define l0_wo (args.in[9])
#define l0_nffn (args.in[10])
#define l0_wg (args.in[11])
#define l0_wu (args.in[12])
#define l0_wd (args.in[13])
#define l1_wada (args.in[14])
#define l1_bada (args.in[15])
#define l1_nmix (args.in[16])
#define l1_wqkv (args.in[17])
#define l1_lq1 (args.in[18])
#define l1_lk1 (args.in[19])
#define l1_lq2 (args.in[20])
#define l1_lk2 (args.in[21])
#define l1_subln (args.in[22])
#define l1_wo (args.in[23])
#define l1_nffn (args.in[24])
#define l1_wr (args.in[25])
#define l1_wg (args.in[26])
#define l1_wu (args.in[27])
#define l1_wd (args.in[28])
#define fnorm (args.in[29])
#define xlat (args.out)
#define xctx ((float*)(args.ws + WS_XCTX))
#define mod ((float*)(args.ws + WS_MOD))
#define rope ((float*)(args.ws + WS_ROPE))
#define tok_e ((int*)(args.ws + WS_TOKE))
#define tok_w ((float*)(args.ws + WS_TOKW))
#define tok_p ((int*)(args.ws + WS_TOKP))
#define tok_s ((int*)(args.ws + WS_TOKS))
#define W0qkv ((bf16*)(args.ws + WS_W0QKV))
#define W0o ((bf16*)(args.ws + WS_W0O))
#define W0gu ((bf16*)(args.ws + WS_W0GU))
#define W0d ((bf16*)(args.ws + WS_W0D))
#define W1qkv ((bf16*)(args.ws + WS_W1QKV))
#define W1o ((bf16*)(args.ws + WS_W1O))
#define WMgu ((bf16*)(args.ws + WS_WMGU))
#define WMd ((bf16*)(args.ws + WS_WMD))
#define Hb ((bf16*)(args.ws + WS_H))
#define Qb ((bf16*)(args.ws + WS_Q))
#define Kb ((bf16*)(args.ws + WS_K))
#define Vb ((bf16*)(args.ws + WS_V))
#define ACT0 ((bf16*)(args.ws + WS_ACT0))
#define APERM ((bf16*)(args.ws + WS_APERM))
#define H2 ((bf16*)(args.ws + WS_H2))
#define ACT1 ((bf16*)(args.ws + WS_ACT1))
#define ctl ((gu32*)(args.ws + WS_CTL))
    for (int u = threadIdx.x; u < (LDS_BYTES - LDSCTL_OFF) / 4; u += NWAVES * 64) ((LAS unsigned*)(lds + LDSCTL_OFF))[u] = 0u;
    __syncthreads();
    XcdBarrier bar = xcd_barrier_post((unsigned*)(ctl + CW_BAR), MISC + 8);
#define GRID_BAR() xcd_barrier(bar)

    {
        PHASE_IDS();
        if (bx < 192) {
            LAS float* sl = (LAS float*)(lds + RING_OFF); LAS float* red = (LAS float*)(lds + RING_OFF + 17 * 1024 * 4);
            for (int i = tid; i < 17 * 1024; i += NWAVES * 64) { const int r = i >> 10, k = i & 1023; const float cv = (r < 16) ? c_in[r * 1024 + k] : cctx_in[k]; sl[i] = cv / (1.0f + __expf(-cv)); }
            __syncthreads();
            const int layer = bx / 96, n0 = (bx % 96) * 64, col = tid & 63, ks = tid >> 6;
            const float* W = (layer ? l1_wada : l0_wada) + n0 + col; const float* bias = (layer ? l1_bada : l0_bada);
            float acc[17];
#pragma unroll
            for (int r = 0; r < 17; ++r) acc[r] = 0.f;
            for (int kk = 0; kk < 128; ++kk) { const int k = ks * 128 + kk; const float w = W[(size_t)k * MODW];
#pragma unroll
                for (int r = 0; r < 17; ++r) acc[r] += sl[r * 1024 + k] * w; }
#pragma unroll
            for (int r = 0; r < 17; ++r) red[(ks * 17 + r) * 64 + col] = acc[r];
            __syncthreads();
            for (int i = tid; i < 17 * 64; i += NWAVES * 64) { const int r = i >> 6, cc = i & 63; float s = bias[n0 + cc];
#pragma unroll
                for (int q = 0; q < 8; ++q) s += red[(q * 17 + r) * 64 + cc];
                mod[(size_t)(layer * 17 + r) * MODW + n0 + cc] = s; }
            __syncthreads();
        }
        if (bx == 192 || (G <= 192 && bx == 0)) {
            for (int i = tid; i < 64 * 16; i += NWAVES * 64) { const int pos = i >> 4, f = i & 15; double inv = 1.0; for (int q = 0; q < f; ++q) inv *= 0.5623413251903491;
                const double a = (double)pos * inv; const double kq = __builtin_rint(a * 0.6366197723675814); const double rr = (a - kq * 1.5707963267948966) - kq * 6.123233995736766e-17; const double r2 = rr * rr;
                double sn = rr * (1.0 + r2 * (-1.0 / 6 + r2 * (1.0 / 120 + r2 * (-1.0 / 5040 + r2 * (1.0 / 362880 + r2 * (-1.0 / 39916800 + r2 * (1.0 / 6227020800.0)))))));
                double cn = 1.0 + r2 * (-0.5 + r2 * (1.0 / 24 + r2 * (-1.0 / 720 + r2 * (1.0 / 40320 + r2 * (-1.0 / 3628800 + r2 * (1.0 / 479001600.0 + r2 * (-1.0 / 87178291200.0)))))));
                const int qd = ((int)kq) & 3; double cs = cn, ss = sn; if (qd == 1) { cs = -sn; ss = cn; } else if (qd == 2) { cs = -cn; ss = -sn; } else if (qd == 3) { cs = sn; ss = -cn; }
                rope[2 * i] = (float)cs; rope[2 * i + 1] = (float)ss; }
        }
        LAS float* scr = (LAS float*)(lds + RING_OFF + wave * 16384);
        int itbase = 0;
#define CVT(SRC, DST, KK, NN, MODE, NMAT) do { const CvtMat cm_{SRC, DST, KK, NN, MODE, NMAT}; const int nit_ = ((KK) / 64) * ((NN) / 32) * (NMAT); \
            int first_ = (gw - itbase) % NGW; if (first_ < 0) first_ += NGW; for (int it = first_; it < nit_; it += NGW) cvt_run(cm_, it, scr, lane); itbase += nit_; } while (0)
        CVT(l0_wqkv, W0qkv, D, 3 * D, 0, 1); CVT(l0_wo, W0o, D, D, 0, 1); CVT(l0_wg, W0gu, D, DFF, 1, 1); CVT(l0_wu, W0gu, D, DFF, 2, 1); CVT(l0_wd, W0d, DFF, D, 0, 1);
        CVT(l1_wqkv, W1qkv, D, 3 * D, 0, 1); CVT(l1_wo, W1o, D, D, 0, 1); CVT(l1_wg, WMgu, D, DFE, 1, NE); CVT(l1_wu, WMgu, D, DFE, 2, NE); CVT(l1_wd, WMd, DFE, D, 0, NE);
#undef CVT
    }
    GRID_BAR();

    { PHASE_IDS();
    for (int m = gw; m < MT; m += NGW) { const bool lat = m < ML; const int br = lat ? (m >> 11) : 16; const float* mp = mod + (size_t)br * MODW; f32x4 v[4];
        norm_mod_row(lat ? x_in + (size_t)m * D : ctx_in + (size_t)(m - ML) * D, l0_nmix, mp, mp + D, Hb + (size_t)m * D, lane, v); } }
    GRID_BAR();

    { PHASE_IDS(); pg8::Gemm g{Hb, W0qkv, MT, 3 * D, D}; pg8::StaticOrder S; S.init(MT, 3 * D, G, bx);
      pg8::EpiQKV<false> E{Qb, (size_t)MT * D, nullptr};
      pg8::gemm_phase<pg8::EpiQKV<false>, pg8::StaticOrder, true, true>(lds + RING_OFF, g, S, E, tid); }
    GRID_BAR();

    { PHASE_IDS();
    for (int bh = vcu; bh < NB * 16; bh += G)
        for (int rg = 0; rg < 9; ++rg) att::na_unit(bh >> 4, bh & 15, rg, Qb, Kb, Vb, Qb, l0_rpb, lds + RING_OFF, tid); }
    GRID_BAR();

    { PHASE_IDS(); pg8::Gemm g{Qb, W0o, MT, D, D}; pg8::StaticOrder S; S.init(MT, D, G, bx);
      pg8::EpiResid E{x_in, ctx_in, xlat, xctx, mod + 2 * D};
      pg8::gemm_phase<pg8::EpiResid, pg8::StaticOrder, true, true>(lds + RING_OFF, g, S, E, tid); }
    GRID_BAR();

    { PHASE_IDS();
    for (int m = gw; m < MT; m += NGW) { const bool lat = m < ML; const int br = lat ? (m >> 11) : 16; const float* mp = mod + (size_t)br * MODW; f32x4 v[4];
        norm_mod_row(lat ? xlat + (size_t)m * D : xctx + (size_t)(m - ML) * D, l0_nffn, mp + 3 * D, mp + 4 * D, Hb + (size_t)m * D, lane, v); } }
    GRID_BAR();

    { PHASE_IDS(); pg8::Gemm g{Hb, W0gu, MT, 2 * DFF, D}; pg8::StaticOrder S; S.init(MT, 2 * DFF, G, bx);
      pg8::EpiSwiGLU E{ACT0, DFF, 0, nullptr, 0};
      pg8::gemm_phase<pg8::EpiSwiGLU, pg8::StaticOrder, true, true>(lds + RING_OFF, g, S, E, tid); }
    GRID_BAR();

    { PHASE_IDS(); pg8::Gemm g{ACT0, W0d, MT, D, DFF}; pg8::StaticOrder S; S.init(MT, D, G, bx);
      pg8::EpiResid E{xlat, xctx, xlat, xctx, mod + 5 * D};
      pg8::gemm_phase<pg8::EpiResid, pg8::StaticOrder, true, true>(lds + RING_OFF, g, S, E, tid); }
    GRID_BAR();

    { PHASE_IDS();
    for (int m = gw; m < MT; m += NGW) { const bool lat = m < ML; const int br = lat ? (m >> 11) : 16; const float* mp = mod + (size_t)(17 + br) * MODW; f32x4 v[4];
        norm_mod_row(lat ? xlat + (size_t)m * D : xctx + (size_t)(m - ML) * D, l1_nmix, mp, mp + D, Hb + (size_t)m * D, lane, v); } }
    GRID_BAR();

    { PHASE_IDS(); pg8::Gemm g{Hb, W1qkv, MT, 3 * D, D}; pg8::StaticOrder S; S.init(MT, 3 * D, G, bx);
      pg8::EpiQKV<true> E{Qb, (size_t)MT * D, rope};
      pg8::gemm_phase<pg8::EpiQKV<true>, pg8::StaticOrder, true, true>(lds + RING_OFF, g, S, E, tid); }
    GRID_BAR();

    {
        PHASE_IDS();
        float d1 = 0.f, d2 = 0.f; d1 = l1_lq1[lane] * l1_lk1[lane]; d2 = l1_lq2[lane] * l1_lk2[lane];
        const float lam = __expf(wave_sum(d1)) - __expf(wave_sum(d2)) + LAM_INIT;
        const int nu = NB * 8 * 8, per = (nu + G - 1) / G;
        for (int i = 0; i < per; ++i) { const int u = vcu * per + i; if (u >= nu) break;
            att::diff_unit(u >> 6, (u >> 3) & 7, u & 7, Qb, Kb, Vb, Qb, lam, 1.0f - LAM_INIT, l1_subln, lds + RING_OFF, tid); }
    }
    GRID_BAR();

    { PHASE_IDS(); pg8::Gemm g{Qb, W1o, ML, D, D}; pg8::StaticOrder S; S.init(ML, D, G, bx);
      pg8::EpiResid E{xlat, xctx, xlat, xctx, mod + (size_t)17 * MODW + 2 * D};
      pg8::gemm_phase<pg8::EpiResid, pg8::StaticOrder, true, true>(lds + RING_OFF, g, S, E, tid); }
    GRID_BAR();

    {
        PHASE_IDS();
        LAS float* wrl = (LAS float*)(lds + RING_OFF);
        LAS int* lcnt = (LAS int*)(lds + RING_OFF + 32768);
        LAS int* rec = (LAS int*)(lds + RING_OFF + 32768 + 64);
        for (int i = tid; i < 8192; i += NWAVES * 64) wrl[i] = l1_wr[i];
        if (tid < 16) lcnt[tid] = 0;
        __syncthreads();
        const int rows_per = (ML + G - 1) / G;
        const int row_lo = vcu * rows_per, row_hi = (row_lo + rows_per < ML) ? row_lo + rows_per : ML;
        for (int m = row_lo + wave; m < row_hi; m += NWAVES) { const int br = m >> 11; const float* mp = mod + (size_t)(17 + br) * MODW; f32x4 v[4];
            norm_mod_row(xlat + (size_t)m * D, l1_nffn, mp + 3 * D, mp + 4 * D, H2 + (size_t)m * D, lane, v);
            float lg[8];
#pragma unroll
            for (int e = 0; e < 8; ++e) lg[e] = 0.f;
#pragma unroll
            for (int j = 0; j < 4; ++j)
#pragma unroll
                for (int q = 0; q < 4; ++q) { const int k = 4 * lane + 256 * j + q; const f32x4 w0 = *(const LAS f32x4*)(wrl + k * 8), w1 = *(const LAS f32x4*)(wrl + k * 8 + 4); const float hv = v[j][q];
                    lg[0] += hv * w0[0]; lg[1] += hv * w0[1]; lg[2] += hv * w0[2]; lg[3] += hv * w0[3]; lg[4] += hv * w1[0]; lg[5] += hv * w1[1]; lg[6] += hv * w1[2]; lg[7] += hv * w1[3]; }
#pragma unroll
            for (int e = 0; e < 8; ++e) lg[e] = wave_sum(lg[e]);
            int e0 = 0; float b0 = lg[0];
#pragma unroll
            for (int e = 1; e < 8; ++e) if (lg[e] > b0) { b0 = lg[e]; e0 = e; }
            int e1 = -1; float b1 = -INFINITY;
#pragma unroll
            for (int e = 0; e < 8; ++e) if (e != e0 && lg[e] > b1) { b1 = lg[e]; e1 = e; }
            if (lane == 0) { const float w0 = 1.0f / (1.0f + __expf(b1 - b0)); const int lr = m - row_lo;
                const int p0 = __hip_atomic_fetch_add(&lcnt[e0], 1, __ATOMIC_RELAXED, __HIP_MEMORY_SCOPE_WORKGROUP), p1 = __hip_atomic_fetch_add(&lcnt[e1], 1, __ATOMIC_RELAXED, __HIP_MEMORY_SCOPE_WORKGROUP);
                rec[lr * 6 + 0] = e0; rec[lr * 6 + 1] = e1; rec[lr * 6 + 2] = p0; rec[lr * 6 + 3] = p1; ((LAS float*)rec)[lr * 6 + 4] = w0; ((LAS float*)rec)[lr * 6 + 5] = 1.0f - w0; }
        }
        __syncthreads();
        if (tid < 8) lcnt[8 + tid] = (int)__hip_atomic_fetch_add(ctl + CW_CNT + 64 * tid, (unsigned)lcnt[tid], RLX_AGENT);
        __syncthreads();
        for (int lr = tid; lr < row_hi - row_lo; lr += NWAVES * 64) { const int m = row_lo + lr; const int e0 = rec[lr * 6], e1 = rec[lr * 6 + 1];
            tok_e[2 * m] = e0; tok_e[2 * m + 1] = e1; tok_p[2 * m] = lcnt[8 + e0] + rec[lr * 6 + 2]; tok_p[2 * m + 1] = lcnt[8 + e1] + rec[lr * 6 + 3];
            tok_w[2 * m] = ((LAS float*)rec)[lr * 6 + 4]; tok_w[2 * m + 1] = ((LAS float*)rec)[lr * 6 + 5]; }
    }
    GRID_BAR();

    {
        PHASE_IDS();
        if (tid == 0) { int base = 0; for (int e = 0; e < 8; ++e) { ebase[e] = base; const int n = (int)__hip_atomic_load(ctl + CW_CNT + 64 * e, RLX_AGENT); ebase[9 + e] = n; const int nt = (n + 255) >> 8;
                for (int t = 0; t < nt; ++t) tile_e[(base >> 8) + t] = e; base += nt << 8; } ebase[8] = base; }
        __syncthreads();
        for (int m = gw; m < ML; m += NGW) { const v4u* src = (const v4u*)(H2 + (size_t)m * D); const v4u a = src[lane], b = src[lane + 64];
#pragma unroll
            for (int k = 0; k < 2; ++k) { const int e = tok_e[2 * m + k], slot = ebase[e] + tok_p[2 * m + k]; if (lane == 0) tok_s[2 * m + k] = slot;
                v4u* dst = (v4u*)(APERM + (size_t)slot * D); dst[lane] = a; dst[lane + 64] = b; } }
        for (int i = gw; i < 8 * 256; i += NGW) { const int e = i >> 8, j = i & 255, n = ebase[9 + e], pad = ebase[e + 1] - ebase[e] - n;
            if (j < pad) { v4u* dst = (v4u*)(APERM + (size_t)(ebase[e] + n + j) * D); const v4u z = {0u, 0u, 0u, 0u}; dst[lane] = z; dst[lane + 64] = z; } }
    }
    GRID_BAR();

    {
        const int T = ebase[8] >> 8;
#pragma unroll
        for (int ch = 0; ch < 2; ++ch) {
            const int t0 = ch * MOE_CHUNK; int nt = T - t0; nt = nt > MOE_CHUNK ? MOE_CHUNK : nt; if (nt < 0) nt = 0;
            { PHASE_IDS(); pg8::Gemm g{APERM, WMgu, 0, 0, D}; pg8::MoeOrder S; S.init(nt, 2 * DFE / 256, G, bx, t0, tile_e);
              pg8::EpiSwiGLU E{ACT1, DFE, t0 * 256, tile_e, 2 * DFE / 256};
              pg8::gemm_phase<pg8::EpiSwiGLU, pg8::MoeOrder, true, true>(lds + RING_OFF, g, S, E, tid); }
            GRID_BAR();
            { PHASE_IDS(); pg8::Gemm g{ACT1 - (size_t)t0 * 256 * DFE, WMd, 0, 0, DFE}; pg8::MoeOrder S; S.init(nt, D / 256, G, bx, t0, tile_e);
              pg8::EpiBf16Grp E{APERM, tile_e, D / 256};
              pg8::gemm_phase<pg8::EpiBf16Grp, pg8::MoeOrder, true, true>(lds + RING_OFF, g, S, E, tid); }
            GRID_BAR();
        }
    }

    { PHASE_IDS();
    for (int m = gw; m < ML; m += NGW) { const int br = m >> 11; const float* g2 = mod + (size_t)(17 + br) * MODW + 5 * D;
        const int s0 = tok_s[2 * m], s1 = tok_s[2 * m + 1]; const float w0 = tok_w[2 * m], w1 = tok_w[2 * m + 1];
        GAS f32x4* xr = (GAS f32x4*)(xlat + (size_t)m * D) + lane;
        const unsigned long long* y0 = (const unsigned long long*)(APERM + (size_t)s0 * D) + lane; const unsigned long long* y1 = (const unsigned long long*)(APERM + (size_t)s1 * D) + lane;
        f32x4 v[4]; float s2 = 0.f;
#pragma unroll
        for (int j = 0; j < 4; ++j) { const unsigned long long a = y0[64 * j], b = y1[64 * j]; const f32x4 gg = ((const f32x4*)g2)[lane + 64 * j];
            f32x4 ya, yb; ya.x = __uint_as_float((unsigned)a << 16); ya.y = __uint_as_float((unsigned)a & 0xffff0000u); ya.z = __uint_as_float((unsigned)(a >> 32) << 16); ya.w = __uint_as_float((unsigned)(a >> 32) & 0xffff0000u);
            yb.x = __uint_as_float((unsigned)b << 16); yb.y = __uint_as_float((unsigned)b & 0xffff0000u); yb.z = __uint_as_float((unsigned)(b >> 32) << 16); yb.w = __uint_as_float((unsigned)(b >> 32) & 0xffff0000u);
            v[j] = xr[64 * j] + gg * (ya * w0 + yb * w1); s2 += (v[j].x * v[j].x + v[j].y * v[j].y) + (v[j].z * v[j].z + v[j].w * v[j].w); }
        const float rstd = 1.0f / sqrtf(wave_sum(s2) * (1.f / D) + EPS);
#pragma unroll
        for (int j = 0; j < 4; ++j) xr[64 * j] = v[j] * rstd * ((const f32x4*)fnorm)[lane + 64 * j];
    } }
#undef GRID_BAR
}

extern "C" void kernel_launch(void* const* d_in, const int* in_sizes, int n_in, void* d_out, int out_size, void* d_ws, size_t ws_size, hipStream_t stream) {
    static int grid = 0;
    if (grid == 0) {
        if (n_in != 30 || out_size != ML * D || ws_size < WS_END) { fprintf(stderr, "kernel_launch: built for 30 inputs, out of %d floats, >= %zu bytes of workspace; got n_in %d, out %d, ws %zu; nothing launched\n", ML * D, (size_t)WS_END, n_in, out_size, ws_size); grid = -1; return; }
        int dev = 0, cus = 0, per_cu = 0;
        if (hipGetDevice(&dev) != hipSuccess || hipDeviceGetAttribute(&cus, hipDeviceAttributeMultiprocessorCount, dev) != hipSuccess) { grid = -1; return; }
        if (hipFuncSetAttribute((const void*)mega_fwd, hipFuncAttributeMaxDynamicSharedMemorySize, LDS_BYTES) != hipSuccess) { fprintf(stderr, "kernel_launch: hipFuncSetAttribute failed\n"); grid = -1; return; }
        if (hipOccupancyMaxActiveBlocksPerMultiprocessor(&per_cu, (const void*)mega_fwd, NWAVES * 64, LDS_BYTES) != hipSuccess || per_cu < 1)
            fprintf(stderr, "kernel_launch: note: occupancy query reports %d workgroups per CU\n", per_cu);
        (void)hipGetLastError();
        grid = cus;
    }
    if (grid < 0) return;
    if (hipMemsetAsync((char*)d_ws + WS_CTL, 0, CTL_ZERO_BYTES, stream) != hipSuccess) return;
    Args a{};
    for (int i = 0; i < 30; ++i) a.in[i] = (const float*)d_in[i];
    a.out = (float*)d_out; a.ws = (unsigned char*)d_ws;
    hipLaunchKernelGGL(mega_fwd, dim3(grid), dim3(NWAVES * 64), LDS_BYTES, stream, a);
}
```

```cpp
#include <hip/hip_runtime.h>
#include <cstdio>
#include <cstdint>
#include <cmath>
namespace xl {
template <int X> __device__ __forceinline__ float swz_xor(float v) { return __builtin_bit_cast(float, __builtin_amdgcn_ds_swizzle(__builtin_bit_cast(int, v), (X << 10) | 0x1f)); }
__device__ __forceinline__ void swap32(float& a, float& b) { asm volatile("v_nop\n\tv_nop\n\tv_permlane32_swap_b32 %0, %1" : "+v"(a), "+v"(b)); }
__device__ __forceinline__ float half_max(float v) { float a = v, b = v; swap32(a, b); return fmaxf(a, b); }
__device__ __forceinline__ float half_sum(float v) { float a = v, b = v; swap32(a, b); return a + b; }
__device__ __forceinline__ float other_half(float v) { float a = v, b = v; swap32(a, b);
    int lane_hi; asm("v_mbcnt_lo_u32_b32 %0, -1, 0\n\tv_mbcnt_hi_u32_b32 %0, -1, %0" : "=v"(lane_hi)); return (lane_hi >= 32) ? a : b; }
}
namespace pg8 {
#define PG8_LAS __attribute__((address_space(3)))
typedef unsigned short bf16_t;
typedef short bf16x8 __attribute__((ext_vector_type(8)));
typedef float f32x4 __attribute__((ext_vector_type(4)));
typedef unsigned u32x4 __attribute__((ext_vector_type(4)));
typedef int i32x4_t __attribute__((ext_vector_type(4)));
typedef int i32x8_t __attribute__((ext_vector_type(8)));
typedef unsigned u32x2 __attribute__((ext_vector_type(2)));
constexpr int BM = 256, BK = 64, HALF = 128, HTB = HALF * BK * 2  , STAGE_BYTES = 8 * HTB, NXCD = 8, WGM = 8;

__host__ __device__ __forceinline__ int lds_byte(int r, int c) { const int st = (r >> 4) * 2 + (c >> 5), rr = r & 15, cc = c & 31, ob = rr * 64 + cc * 2; return st * 1024 + (ob ^ (((ob >> 9) & 1) << 5)); }
__host__ __device__ __forceinline__ void stage_rc(int b, int& R, int& C) { const int st = b / 1024, sb = b % 1024, swz = sb ^ (((sb >> 9) & 1) << 5); R = (st >> 1) * 16 + swz / 64; C = (st & 1) * 32 + (swz % 64) / 2; }
__host__ __device__ __forceinline__ int perm32(int rho) { const int n = rho >> 4, i = rho & 15; return 8 * (i >> 2) + 4 * n + (i & 3); }

struct Unit { int pm, pn; };
struct Gemm { const bf16_t* A; const bf16_t* Bt; int M, N, K; int kt0 = 0, ktn = 0; };

struct StaticOrder {
    int nM, nN, nwg, G, c;
    __host__ __device__ void init(int M, int N, int G_, int c_) { nM = M / BM; nN = N / BM; nwg = nM * nN; G = G_; c = c_; }
    __host__ __device__ bool next(int i, Unit& u) const {
        const long L = (long)i * G + c; if (L >= nwg) return false;
        int wgid = (int)L; { const int q = nwg / NXCD, r = nwg % NXCD, xcd = wgid % NXCD, off = wgid / NXCD; wgid = (xcd < r ? xcd * (q + 1) : r * (q + 1) + (xcd - r) * q) + off; }
        const int nig = WGM * nN, gid = wgid / nig, fm = gid * WGM, gsz = (nM - fm) < WGM ? (nM - fm) : WGM;
        u.pm = fm + ((wgid % nig) % gsz); u.pn = (wgid % nig) / gsz; return true;
    }
    __device__ __forceinline__ void a_ready(const Unit&) const {}
    __device__ __forceinline__ void done(const Unit&) const {}
};

__device__ __forceinline__ unsigned cvt_pk_bf16(float lo, float hi) { unsigned r; asm volatile("v_cvt_pk_bf16_f32 %0, %1, %2" : "=v"(r) : "v"(lo), "v"(hi)); return r; }
typedef float f32x2 __attribute__((ext_vector_type(2)));
constexpr float QSCALE = 0.125f * 1.4426950408889634f;

__device__ __forceinline__ float clamp448(float v) { return __builtin_fminf(__builtin_fmaxf(v, -448.0f), 448.0f); }
__device__ __forceinline__ unsigned pk4_fp8(float a, float b, float c, float d) { int w = 0; w = __builtin_amdgcn_cvt_pk_fp8_f32(clamp448(a), clamp448(b), w, false); w = __builtin_amdgcn_cvt_pk_fp8_f32(clamp448(c), clamp448(d), w, true); return (unsigned)w; }
struct EpiResid {
    static constexpr bool PERM = false, AFTER_DRAIN = false;
    const float* base_lat; const float* base_ctx; float* out_lat; float* out_ctx; const float* gate; float s;
    __device__ __forceinline__ void operator()(const f32x4 (&acc)[2][2][4][2], const Unit& u, int wr, int wc, int fr, int fq) const {
        const bool lat = u.pm < 128;
        const int br = lat ? (u.pm >> 3) : 16;
        const size_t toff = (size_t)(lat ? u.pm : u.pm - 128) * (256 * 1024);
        const float* bs = (lat ? base_lat : base_ctx) + toff; float* os = (lat ? out_lat : out_ctx) + toff;
        const float* gp = gate + br * 6144;
        const int col0 = u.pn * BM + wc * 32 + 4 * fq;
        f32x4 gv[2][2];
#pragma unroll
        for (int bj = 0; bj < 2; ++bj)
#pragma unroll
            for (int n = 0; n < 2; ++n) gv[bj][n] = *(const f32x4*)(gp + col0 + bj * HALF + n * 16) * s;
        f32x4 b[3][2][2];
#define PG8_LDRES(it, buf) do { const size_t off_ = (size_t)(((it) >> 2) * HALF + wr * 64 + ((it) & 3) * 16 + fr) * 1024 + col0; \
            _Pragma("unroll") for (int bj = 0; bj < 2; ++bj) _Pragma("unroll") for (int n = 0; n < 2; ++n) b[buf][bj][n] = *(const f32x4*)(bs + off_ + bj * HALF + n * 16); } while (0)
        PG8_LDRES(0, 0); PG8_LDRES(1, 1);
#pragma unroll
        for (int it = 0; it < 8; ++it) { const int ai = it >> 2, m = it & 3; const size_t off = (size_t)(ai * HALF + wr * 64 + m * 16 + fr) * 1024 + col0;
                if (it + 2 < 8) PG8_LDRES(it + 2, (it + 2) % 3);
#pragma unroll
                for (int bj = 0; bj < 2; ++bj)
#pragma unroll
                    for (int n = 0; n < 2; ++n) *(f32x4*)(os + off + bj * HALF + n * 16) = b[it % 3][bj][n] + gv[bj][n] * acc[ai][bj][m][n];
                asm volatile("" ::: "memory"); }
#undef PG8_LDRES
    }
};

template <bool A8 = false> struct EpiResidNT {
    static constexpr bool PERM = false, AFTER_DRAIN = false;
    const float* base_lat; const float* base_ctx; float* out_lat; float* out_ctx; const float* gate;
    bf16_t* An; const float* ngain; const float* nscale; float* ssq; float s; int mt;
    __device__ __forceinline__ void operator()(const f32x4 (&acc)[2][2][4][2], const Unit& u, int wr, int wc, int fr, int fq) const {
        const bool lat = u.pm < 128;
        const int br = lat ? (u.pm >> 3) : 16;
        const size_t toff = (size_t)(lat ? u.pm : u.pm - 128) * (256 * 1024);
        const float* bs = (lat ? base_lat : base_ctx) + toff; float* os = (lat ? out_lat : out_ctx) + toff;
        const float* gp = gate + br * 6144; const float* sp = nscale + br * 6144;
        const int col0 = u.pn * BM + wc * 32 + 4 * fq;
        f32x4 gv[2][2], uv[2][2], sv[2][2];
#pragma unroll
        for (int bj = 0; bj < 2; ++bj)
#pragma unroll
            for (int n = 0; n < 2; ++n) { gv[bj][n] = *(const f32x4*)(gp + col0 + bj * HALF + n * 16); uv[bj][n] = *(const f32x4*)(ngain + col0 + bj * HALF + n * 16); sv[bj][n] = *(const f32x4*)(sp + col0 + bj * HALF + n * 16); }
        asm volatile("" : "+v"(gv[0][0]), "+v"(gv[0][1]), "+v"(gv[1][0]), "+v"(gv[1][1]), "+v"(uv[0][0]), "+v"(uv[0][1]), "+v"(uv[1][0]), "+v"(uv[1][1]), "+v"(sv[0][0]), "+v"(sv[0][1]), "+v"(sv[1][0]), "+v"(sv[1][1]));
#pragma unroll
        for (int bj = 0; bj < 2; ++bj)
#pragma unroll
            for (int n = 0; n < 2; ++n) { gv[bj][n] = gv[bj][n] * s; uv[bj][n] = uv[bj][n] * (sv[bj][n] + 1.0f); }
        f32x4 b[3][2][2];
#define PG8_LDRES(it, buf) do { const size_t off_ = (size_t)(((it) >> 2) * HALF + wr * 64 + ((it) & 3) * 16 + fr) * 1024 + col0; \
            _Pragma("unroll") for (int bj = 0; bj < 2; ++bj) _Pragma("unroll") for (int n = 0; n < 2; ++n) b[buf][bj][n] = *(const f32x4*)(bs + off_ + bj * HALF + n * 16); } while (0)
        PG8_LDRES(0, 0); PG8_LDRES(1, 1);
#pragma unroll
        for (int it = 0; it < 8; ++it) { const int ai = it >> 2, m = it & 3; const int rl = ai * HALF + wr * 64 + m * 16 + fr; const size_t off = (size_t)rl * 1024 + col0; const int rowg = u.pm * BM + rl;
                if (it + 2 < 8) PG8_LDRES(it + 2, (it + 2) % 3);
                bf16_t* ap = An + (size_t)rowg * 1024 + col0; float ss = 0.f;
#pragma unroll
                for (int bj = 0; bj < 2; ++bj)
#pragma unroll
                    for (int n = 0; n < 2; ++n) { const f32x4 x = b[it % 3][bj][n] + gv[bj][n] * acc[ai][bj][m][n]; *(f32x4*)(os + off + bj * HALF + n * 16) = x;
                        const f32x4 a = x * uv[bj][n];
                        if constexpr (A8) *(unsigned*)((unsigned char*)An + (size_t)rowg * 1024 + col0 + bj * HALF + n * 16) = pk4_fp8(a[0], a[1], a[2], a[3]);
                        else { u32x2 w; w.x = cvt_pk_bf16(a[0], a[1]); w.y = cvt_pk_bf16(a[2], a[3]); *(u32x2*)(ap + bj * HALF + n * 16) = w; }
                        ss += (x[0] * x[0] + x[1] * x[1]) + (x[2] * x[2] + x[3] * x[3]); }
                ss += xl::swz_xor<16>(ss); ss = xl::half_sum(ss);
                if (fq == 0) ssq[(size_t)(u.pn * 4 + wc) * mt + rowg] = ss;
                asm volatile("" ::: "memory"); }
#undef PG8_LDRES
    }
};
typedef EpiResidNT<false> EpiResidN;

__device__ __forceinline__ void rows_rstd(float (&rs)[2][4], const float* ssq, int mt, int row0, int fq) {
    float v[8][4];
#pragma unroll
    for (int i = 0; i < 8; ++i) { const float* p = ssq + (size_t)(4 * fq) * mt + row0 + (i >> 2) * HALF + (i & 3) * 16;
        v[i][0] = p[0]; v[i][1] = p[mt]; v[i][2] = p[2 * (size_t)mt]; v[i][3] = p[3 * (size_t)mt]; }
    asm volatile("" : "+v"(v[0][0]), "+v"(v[0][1]), "+v"(v[0][2]), "+v"(v[0][3]), "+v"(v[1][0]), "+v"(v[1][1]), "+v"(v[1][2]), "+v"(v[1][3]), "+v"(v[2][0]), "+v"(v[2][1]), "+v"(v[2][2]), "+v"(v[2][3]), "+v"(v[3][0]), "+v"(v[3][1]), "+v"(v[3][2]), "+v"(v[3][3]));
    asm volatile("" : "+v"(v[4][0]), "+v"(v[4][1]), "+v"(v[4][2]), "+v"(v[4][3]), "+v"(v[5][0]), "+v"(v[5][1]), "+v"(v[5][2]), "+v"(v[5][3]), "+v"(v[6][0]), "+v"(v[6][1]), "+v"(v[6][2]), "+v"(v[6][3]), "+v"(v[7][0]), "+v"(v[7][1]), "+v"(v[7][2]), "+v"(v[7][3]));
#pragma unroll
    for (int i = 0; i < 8; ++i) { float s = (v[i][0] + v[i][1]) + (v[i][2] + v[i][3]);
        s += xl::swz_xor<16>(s); s = xl::half_sum(s);
        rs[i >> 2][i & 3] = __builtin_amdgcn_rsqf(s * (1.0f / 1024.0f) + 1e-6f); }
}

__device__ __forceinline__ float silu_mul_s(float g, float u, float c1, float c2) { return (g * u) * __builtin_amdgcn_rcpf(__builtin_fmaf(__builtin_amdgcn_exp2f(g * c1), c2, c2)); }
__device__ __forceinline__ float silu_mul(float g, float u) { return g * __builtin_amdgcn_rcpf(1.0f + __builtin_amdgcn_exp2f(-1.4426950408889634f * g)) * u; }
struct EpiSwiGLU {
    static constexpr bool PERM = true, AFTER_DRAIN = false;
    bf16_t* O; int ldc; int row_off; const PG8_LAS int* tile_e; int nN;
    __device__ __forceinline__ void operator()(const f32x4 (&acc)[2][2][4][2], const Unit& u, int wr, int wc, int fr, int fq) const {
        int pnl = u.pn; if (tile_e) pnl -= tile_e[u.pm] * nN;
        const int row0 = u.pm * BM + wr * 64 + fr - row_off, col0 = pnl * HALF + wc * 32 + 8 * fq;
#pragma unroll
        for (int ai = 0; ai < 2; ++ai)
#pragma unroll
            for (int m = 0; m < 4; ++m) { bf16_t* rowp = O + (size_t)(row0 + ai * HALF + m * 16) * ldc + col0;
                const f32x4 g0 = acc[ai][0][m][0], g1 = acc[ai][0][m][1], u0 = acc[ai][1][m][0], u1 = acc[ai][1][m][1];
                u32x4 w; w.x = cvt_pk_bf16(silu_mul(g0[0], u0[0]), silu_mul(g0[1], u0[1])); w.y = cvt_pk_bf16(silu_mul(g0[2], u0[2]), silu_mul(g0[3], u0[3]));
                w.z = cvt_pk_bf16(silu_mul(g1[0], u1[0]), silu_mul(g1[1], u1[1])); w.w = cvt_pk_bf16(silu_mul(g1[2], u1[2]), silu_mul(g1[3], u1[3]));
                *(u32x4*)rowp = w; }
    }
};

struct EpiBf16Grp {
    static constexpr bool PERM = true, AFTER_DRAIN = false;
    bf16_t* O; const PG8_LAS int* tile_e; int nN;
    __device__ __forceinline__ void operator()(const f32x4 (&acc)[2][2][4][2], const Unit& u, int wr, int wc, int fr, int fq) const {
        const int pnl = u.pn - tile_e[u.pm] * nN;
        const int row0 = u.pm * BM + wr * 64 + fr, col0 = pnl * BM + wc * 32 + 8 * fq;
#pragma unroll
        for (int ai = 0; ai < 2; ++ai)
#pragma unroll
            for (int m = 0; m < 4; ++m) { bf16_t* rowp = O + (size_t)(row0 + ai * HALF + m * 16) * 1024 + col0;
#pragma unroll
                for (int bj = 0; bj < 2; ++bj) { const f32x4 v0 = acc[ai][bj][m][0], v1 = acc[ai][bj][m][1];
                    u32x4 w; w.x = cvt_pk_bf16(v0[0], v0[1]); w.y = cvt_pk_bf16(v0[2], v0[3]); w.z = cvt_pk_bf16(v1[0], v1[1]); w.w = cvt_pk_bf16(v1[2], v1[3]);
                    *(u32x4*)(rowp + bj * HALF) = w; } }
    }
};

template <bool ROPE, bool NRM = false, bool QK8 = false, bool VT8 = false> struct EpiQKV {
    static constexpr bool PERM = true, AFTER_DRAIN = false;
    bf16_t* Q; size_t stride; const float* rope; const float* ssq; int mt; const float* cvec; int cn; float s = 1.0f; unsigned char* q8 = nullptr; size_t stride8 = 0; unsigned char* vt = nullptr; PG8_LAS unsigned char* vscr = nullptr;
    __device__ __forceinline__ void operator()(const f32x4 (&acc)[2][2][4][2], const Unit& u, int wr, int wc, int fr, int fq) const {
        const int t = u.pn >> 2, colt = (u.pn & 3) * BM;
        bf16_t* base = Q + (size_t)t * stride;
        const float sc = ((t == 0) ? QSCALE * (QK8 ? 8.0f : 1.0f) : 1.0f) * (NRM ? 1.0f : s);
        const int row0 = u.pm * BM + wr * 64 + fr, col0 = colt + wc * 32 + 8 * fq;
        const bool do_rope = ROPE && t < 2 && u.pm < 128;
        float rs[2][4]; f32x4 cv[2][2];
        if constexpr (NRM) { rows_rstd(rs, ssq, mt, row0, fq);
#pragma unroll
            for (int i_ = 0; i_ < 8; ++i_) rs[i_ >> 2][i_ & 3] *= s; const float* cp = cvec + (size_t)((u.pm < 128) ? (u.pm >> 3) : 16) * cn + u.pn * BM + wc * 32 + 8 * fq;
            cv[0][0] = *(const f32x4*)(cp); cv[0][1] = *(const f32x4*)(cp + 4); cv[1][0] = *(const f32x4*)(cp + HALF); cv[1][1] = *(const f32x4*)(cp + HALF + 4); }
        if (VT8 && t == 2) {
            PG8_LAS unsigned char* vs = vscr + (wr * 4 + wc) * 2048;
            int lx; asm volatile("v_mbcnt_lo_u32_b32 %0, -1, 0\n\tv_mbcnt_hi_u32_b32 %0, -1, %0" : "=v"(lx));
#pragma unroll
            for (int ai = 0; ai < 2; ++ai) { const int rg0 = u.pm * BM + ai * HALF + wr * 64;
                const int bb = (rg0 < 32768) ? (rg0 >> 11) : ((rg0 - 32768) >> 8), T = (rg0 < 32768) ? ((rg0 & 2047) >> 6) : (32 + (((rg0 - 32768) & 255) >> 6));
#pragma unroll
                for (int bj = 0; bj < 2; ++bj) { const int colw = colt + bj * HALF + wc * 32;
#pragma unroll
                    for (int m = 0; m < 4; ++m) { const int k = m * 16 + fr, pos = ((k >> 2) & 1) * 32 + (k >> 5) * 16 + ((k >> 3) & 3) * 4 + (k & 3);
                        f32x4 v0 = acc[ai][bj][m][0], v1 = acc[ai][bj][m][1];
                        if constexpr (NRM) { v0 = v0 * rs[ai][m] + cv[bj][0]; v1 = v1 * rs[ai][m] + cv[bj][1]; } else { v0 = v0 * s; v1 = v1 * s; }
                        const unsigned w0 = pk4_fp8(v0[0], v0[1], v0[2], v0[3]), w1 = pk4_fp8(v1[0], v1[1], v1[2], v1[3]);
#pragma unroll
                        for (int e = 0; e < 4; ++e) { vs[(8 * fq + e) * 64 + pos] = (unsigned char)(w0 >> (8 * e)); vs[(8 * fq + e + 4) * 64 + pos] = (unsigned char)(w1 >> (8 * e)); } }
                    asm volatile("s_waitcnt lgkmcnt(0)" ::: "memory");
                    const u32x4 x0 = *(const PG8_LAS u32x4*)(vs + (lx >> 1) * 64 + (lx & 1) * 32), x1 = *(const PG8_LAS u32x4*)(vs + (lx >> 1) * 64 + (lx & 1) * 32 + 16);
                    unsigned char* vp = vt + ((size_t)((bb * 8 + (colw >> 7)) * 128 + (colw & 127) + (lx >> 1)) * 36 + T) * 64 + (lx & 1) * 32;
                    *(u32x4*)vp = x0; *(u32x4*)(vp + 16) = x1;
                    asm volatile("s_waitcnt lgkmcnt(0)" ::: "memory"); } }
            return;
        }
#pragma unroll
        for (int ai = 0; ai < 2; ++ai)
#pragma unroll
            for (int m = 0; m < 4; ++m) { const int row = row0 + ai * HALF + m * 16; bf16_t* rowp = base + (size_t)row * 1024 + col0;
                f32x4 cs[4];
                if (do_rope) { const int tok = row & 2047, pos = (wc & 1) ? (tok & 63) : (tok >> 6); const f32x4* cp = (const f32x4*)(rope + (pos * 16 + 8 * (fq & 1)) * 2);
                    cs[0] = cp[0]; cs[1] = cp[1]; cs[2] = cp[2]; cs[3] = cp[3]; }
#pragma unroll
                for (int bj = 0; bj < 2; ++bj) { f32x4 v0 = acc[ai][bj][m][0], v1 = acc[ai][bj][m][1];
                    if constexpr (NRM) { v0 = v0 * rs[ai][m] + cv[bj][0]; v1 = v1 * rs[ai][m] + cv[bj][1]; }
                    if (do_rope) {
                        f32x4 p0, p1;
#pragma unroll
                        for (int j = 0; j < 4; ++j) { p0[j] = xl::other_half(v0[j]); p1[j] = xl::other_half(v1[j]); }
                        const float sg = (fq < 2) ? -1.0f : 1.0f;
                        v0[0] = v0[0] * cs[0][0] + sg * p0[0] * cs[0][1]; v0[1] = v0[1] * cs[0][2] + sg * p0[1] * cs[0][3];
                        v0[2] = v0[2] * cs[1][0] + sg * p0[2] * cs[1][1]; v0[3] = v0[3] * cs[1][2] + sg * p0[3] * cs[1][3];
                        v1[0] = v1[0] * cs[2][0] + sg * p1[0] * cs[2][1]; v1[1] = v1[1] * cs[2][2] + sg * p1[1] * cs[2][3];
                        v1[2] = v1[2] * cs[3][0] + sg * p1[2] * cs[3][1]; v1[3] = v1[3] * cs[3][2] + sg * p1[3] * cs[3][3];
                    }
                    v0 = v0 * sc; v1 = v1 * sc;
                    if (QK8 && t < 2) { u32x2 w8; w8.x = pk4_fp8(v0[0], v0[1], v0[2], v0[3]); w8.y = pk4_fp8(v1[0], v1[1], v1[2], v1[3]); *(u32x2*)(q8 + (size_t)t * stride8 + (size_t)row * 1024 + col0 + bj * HALF) = w8; }
                    else { u32x4 w; w.x = cvt_pk_bf16(v0[0], v0[1]); w.y = cvt_pk_bf16(v0[2], v0[3]); w.z = cvt_pk_bf16(v1[0], v1[1]); w.w = cvt_pk_bf16(v1[2], v1[3]);
                    *(u32x4*)(rowp + bj * HALF) = w; } } }
    }
};

template <int XE = 0> struct EpiSwiGLU8T {
    static constexpr bool PERM = true, AFTER_DRAIN = false;
    unsigned char* O; int ldc; int row_off; const PG8_LAS int* tile_e; int nN; float s;
    __device__ __forceinline__ void operator()(const f32x4 (&acc)[2][2][4][2], const Unit& u, int wr, int wc, int fr, int fq) const {
        int pnl = u.pn; if (tile_e) pnl -= tile_e[u.pm] * nN;
        const int row0 = u.pm * BM + wr * 64 + fr - row_off, col0 = pnl * HALF + wc * 32 + 8 * fq;
#pragma unroll
        for (int ai = 0; ai < 2; ++ai)
#pragma unroll
            for (int m = 0; m < 4; ++m) { unsigned char* rowp = O + (size_t)(row0 + ai * HALF + m * 16) * ldc + col0;
                const f32x4 g0 = acc[ai][0][m][0] * s, g1 = acc[ai][0][m][1] * s, u0 = acc[ai][1][m][0] * s, u1 = acc[ai][1][m][1] * s;
                u32x2 w; if (XE == 2) { const float c1 = -1.4426950408889634f * s, c2 = 1.0f / (s * s); const f32x4 a0 = acc[ai][0][m][0], a1 = acc[ai][0][m][1], b0 = acc[ai][1][m][0], b1 = acc[ai][1][m][1];
                    w.x = pk4_fp8(silu_mul_s(a0[0], b0[0], c1, c2), silu_mul_s(a0[1], b0[1], c1, c2), silu_mul_s(a0[2], b0[2], c1, c2), silu_mul_s(a0[3], b0[3], c1, c2));
                    w.y = pk4_fp8(silu_mul_s(a1[0], b1[0], c1, c2), silu_mul_s(a1[1], b1[1], c1, c2), silu_mul_s(a1[2], b1[2], c1, c2), silu_mul_s(a1[3], b1[3], c1, c2)); }
                else if (XE == 1) { w.x = pk4_fp8(g0[0] * u0[0], g0[1] * u0[1], g0[2] * u0[2], g0[3] * u0[3]); w.y = pk4_fp8(g1[0] * u1[0], g1[1] * u1[1], g1[2] * u1[2], g1[3] * u1[3]); } else {
                w.x = pk4_fp8(silu_mul(g0[0], u0[0]), silu_mul(g0[1], u0[1]), silu_mul(g0[2], u0[2]), silu_mul(g0[3], u0[3]));
                w.y = pk4_fp8(silu_mul(g1[0], u1[0]), silu_mul(g1[1], u1[1]), silu_mul(g1[2], u1[2]), silu_mul(g1[3], u1[3])); }
                *(u32x2*)rowp = w; }
    }
};
typedef EpiSwiGLU8T<0> EpiSwiGLU8;

struct EpiSwiGLU8N {
    static constexpr bool PERM = true, AFTER_DRAIN = false;
    unsigned char* O; int ldc; const float* ssq; int mt; const float* cvec; int cn;
    __device__ __forceinline__ void operator()(const f32x4 (&acc)[2][2][4][2], const Unit& u, int wr, int wc, int fr, int fq) const {
        const int br = (u.pm < 128) ? (u.pm >> 3) : 16;
        const int row0 = u.pm * BM + wr * 64 + fr, col0 = u.pn * HALF + wc * 32 + 8 * fq;
        const float* cp = cvec + (size_t)br * cn + u.pn * BM + wc * 32 + 8 * fq;
        f32x4 cg0 = *(const f32x4*)(cp), cg1 = *(const f32x4*)(cp + 4), cu0 = *(const f32x4*)(cp + HALF), cu1 = *(const f32x4*)(cp + HALF + 4);
        float rs[2][4]; rows_rstd(rs, ssq, mt, row0, fq);
        asm volatile("" : "+v"(cg0), "+v"(cg1), "+v"(cu0), "+v"(cu1));
#pragma unroll
        for (int ai = 0; ai < 2; ++ai)
#pragma unroll
            for (int m = 0; m < 4; ++m) { unsigned char* rowp = O + (size_t)(row0 + ai * HALF + m * 16) * ldc + col0; const float r = rs[ai][m];
                const f32x4 g0 = acc[ai][0][m][0] * r + cg0, g1 = acc[ai][0][m][1] * r + cg1, u0 = acc[ai][1][m][0] * r + cu0, u1 = acc[ai][1][m][1] * r + cu1;
                u32x2 w; w.x = pk4_fp8(silu_mul(g0[0], u0[0]), silu_mul(g0[1], u0[1]), silu_mul(g0[2], u0[2]), silu_mul(g0[3], u0[3]));
                w.y = pk4_fp8(silu_mul(g1[0], u1[0]), silu_mul(g1[1], u1[1]), silu_mul(g1[2], u1[2]), silu_mul(g1[3], u1[3]));
                *(u32x2*)rowp = w; }
    }
};
struct EpiBf16GrpS {
    static constexpr bool PERM = true, AFTER_DRAIN = false;
    bf16_t* O; const PG8_LAS int* tile_e; int nN; float s;
    __device__ __forceinline__ void operator()(const f32x4 (&acc)[2][2][4][2], const Unit& u, int wr, int wc, int fr, int fq) const {
        const int pnl = u.pn - tile_e[u.pm] * nN;
        const int row0 = u.pm * BM + wr * 64 + fr, col0 = pnl * BM + wc * 32 + 8 * fq;
#pragma unroll
        for (int ai = 0; ai < 2; ++ai)
#pragma unroll
            for (int m = 0; m < 4; ++m) { bf16_t* rowp = O + (size_t)(row0 + ai * HALF + m * 16) * 1024 + col0;
#pragma unroll
                for (int bj = 0; bj < 2; ++bj) { const f32x4 v0 = acc[ai][bj][m][0] * s, v1 = acc[ai][bj][m][1] * s;
                    u32x4 w; w.x = cvt_pk_bf16(v0[0], v0[1]); w.y = cvt_pk_bf16(v0[2], v0[3]); w.z = cvt_pk_bf16(v1[0], v1[1]); w.w = cvt_pk_bf16(v1[2], v1[3]);
                    *(u32x4*)(rowp + bj * HALF) = w; } }
    }
};

struct EpiPart {
    static constexpr bool PERM = true, AFTER_DRAIN = false;
    float* P; float s;
    __device__ __forceinline__ void operator()(const f32x4 (&acc)[2][2][4][2], const Unit&, int wr, int wc, int fr, int fq) const {
#pragma unroll
        for (int ai = 0; ai < 2; ++ai)
#pragma unroll
            for (int m = 0; m < 4; ++m) { float* rowp = P + (size_t)(ai * HALF + wr * 64 + m * 16 + fr) * 256 + wc * 32 + 8 * fq;
#pragma unroll
                for (int bj = 0; bj < 2; ++bj) { *(f32x4*)(rowp + bj * HALF) = acc[ai][bj][m][0] * s; *(f32x4*)(rowp + bj * HALF + 4) = acc[ai][bj][m][1] * s; } }
    }
};

struct MoeOrder {
    int T, nN, G, c, Lcap; const PG8_LAS int* tile_e;
    __device__ __forceinline__ void init(int T_, int nN_, int G_, int c_, const PG8_LAS int* te) { T = T_; nN = nN_; G = G_; c = c_; tile_e = te; Lcap = T_ * nN_; }
    __device__ __forceinline__ bool next(int i, Unit& u) const {
        const int L = i * G + c; if (L >= Lcap) return false;
        const int Tf = T & ~7, nfull = Tf * nN; int pm, pl;
        if (L < nfull) { const int blk = L >> 5, r = L & 31, nb = nN >> 2; pm = (blk / nb) * 8 + (r & 7); pl = (blk % nb) * 4 + (r >> 3); }
        else { const int Lr = L - nfull; pm = Tf + Lr / nN; pl = Lr % nN; }
        u.pm = pm; u.pn = tile_e[pm] * nN + pl; return true;
    }
    __device__ __forceinline__ void a_ready(const Unit&) const {}
    __device__ __forceinline__ void done(const Unit&) const {}
};

template <class Epi, class Sched, bool ALIGN_EPI = false, bool SP2 = false, bool FP8 = false>
__device__ __forceinline__ void gemm_phase(PG8_LAS unsigned char* lds, const Gemm g, const Sched& S, const Epi& E, int tid_in) {
    int tid_l = tid_in; asm volatile("" : "+v"(tid_l));
    const int tid = tid_l, wid = __builtin_amdgcn_readfirstlane(tid >> 6), lane = tid & 63, wr = wid >> 2, wc = wid & 3, fr = lane & 15, fq = lane >> 4;
    const int K = g.K, nt = g.ktn ? g.ktn : K / BK;
    unsigned voffA[1], voffB[1];
    { int R, C; stage_rc(tid * 16, R, C); const int Rb = Epi::PERM ? ((R & ~31) + perm32(R & 31)) : R;
        voffA[0] = (unsigned)(R * K + C) * 2u; voffB[0] = (unsigned)(Rb * K + C) * 2u; }
    const size_t rstep64 = (size_t)64 * K * 2;
    const size_t kstep = (size_t)(BK * 2);
    const size_t hstep = (size_t)HALF * K * 2;
    const size_t tstep = 2 * hstep;
    const unsigned ldsw = (unsigned)wid * 1024u;
    const unsigned ldsbase = (unsigned)__builtin_amdgcn_readfirstlane((int)((unsigned)(uintptr_t)lds + ldsw));
    const int aoff = lds_byte(wr * 64 + fr, fq * 8), boff = lds_byte(wc * 32 + fr, fq * 8);
#define PG8_SA(b, h) (((b) * 2 + (h)) * HTB)
#define PG8_SB(b, h) ((4 + (b) * 2 + (h)) * HTB)
#define PG8_DMA1(ldsimm, gptr, vo) do { unsigned keep_; asm volatile("s_mov_b32 %0, m0\n\ts_add_i32 m0, %3, %4\n\ts_nop 0\n\tglobal_load_lds_dwordx4 %1, %2\n\ts_mov_b32 m0, %0" \
        : "=&s"(keep_) : "v"(vo), "s"((const char*)(gptr)), "s"(ldsbase), "n"(ldsimm) : "memory", "scc"); } while (0)
#define PG8_STAGE(bufoff, gbase, voff) do { PG8_DMA1((bufoff), (gbase), (voff)[0]); PG8_DMA1((bufoff) + 8192, (const char*)(gbase) + rstep64, (voff)[0]); } while (0)
#define PG8_LDA(dst, b, h) do { if constexpr (FP8) { _Pragma("unroll") for (int m = 0; m < 4; ++m) dst##8[m] = __builtin_shufflevector(*(const PG8_LAS i32x4_t*)(lds + PG8_SA(b, h) + aoff + m * 2048), *(const PG8_LAS i32x4_t*)(lds + PG8_SA(b, h) + aoff + m * 2048 + 1024), 0, 1, 2, 3, 4, 5, 6, 7); } \
        else { _Pragma("unroll") for (int m = 0; m < 4; ++m) _Pragma("unroll") for (int k = 0; k < 2; ++k) dst[m][k] = *(const PG8_LAS bf16x8*)(lds + PG8_SA(b, h) + aoff + m * 2048 + k * 1024); } } while (0)
#define PG8_LDB(dst, b, h) do { if constexpr (FP8) { _Pragma("unroll") for (int n = 0; n < 2; ++n) dst##8[n] = __builtin_shufflevector(*(const PG8_LAS i32x4_t*)(lds + PG8_SB(b, h) + boff + n * 2048), *(const PG8_LAS i32x4_t*)(lds + PG8_SB(b, h) + boff + n * 2048 + 1024), 0, 1, 2, 3, 4, 5, 6, 7); } \
        else { _Pragma("unroll") for (int n = 0; n < 2; ++n) _Pragma("unroll") for (int k = 0; k < 2; ++k) dst[n][k] = *(const PG8_LAS bf16x8*)(lds + PG8_SB(b, h) + boff + n * 2048 + k * 1024); } } while (0)
#define PG8_MMA(ai, bj, At, Bt) do { __builtin_amdgcn_s_setprio(1); \
        if constexpr (FP8) { _Pragma("unroll") for (int m = 0; m < 4; ++m) _Pragma("unroll") for (int n = 0; n < 2; ++n) \
            acc[ai][bj][m][n] = __builtin_amdgcn_mfma_scale_f32_16x16x128_f8f6f4(Bt##8[n], At##8[m], acc[ai][bj][m][n], 0, 0, 0, 0x7f7f7f7f, 0, 0x7f7f7f7f); } \
        else { _Pragma("unroll") for (int m = 0; m < 4; ++m) _Pragma("unroll") for (int n = 0; n < 2; ++n) _Pragma("unroll") for (int k = 0; k < 2; ++k) \
            acc[ai][bj][m][n] = __builtin_amdgcn_mfma_f32_16x16x32_bf16(Bt[n][k], At[m][k], acc[ai][bj][m][n], 0, 0, 0); } \
        __builtin_amdgcn_s_setprio(0); } while (0)
#define PG8_WAIT_V(n) asm volatile("s_waitcnt vmcnt(" #n ")" ::: "memory")
#define PG8_WAIT_L(n) asm volatile("s_waitcnt lgkmcnt(" #n ")" ::: "memory")
#define PG8_BAR __builtin_amdgcn_s_barrier()
#define PG8_SCHED __builtin_amdgcn_sched_barrier(0)
    Unit cur, nxt; int ui = 0;
    if (!S.next(0, cur)) return;
    f32x4 acc[2][2][4][2];
#pragma unroll
    for (int a = 0; a < 2; ++a)
#pragma unroll
        for (int b = 0; b < 2; ++b)
#pragma unroll
            for (int m = 0; m < 4; ++m)
#pragma unroll
                for (int n = 0; n < 2; ++n) acc[a][b][m][n] = (f32x4){0.f, 0.f, 0.f, 0.f};
    bf16x8 At[4][2], B0[2][2], B1[2][2]; i32x8_t At8[4], B08[2], B18[2];
    const size_t koff = (size_t)g.kt0 * kstep;
    const char* cA = (const char*)g.A + (size_t)cur.pm * tstep + koff; const char* cB = (const char*)g.Bt + (size_t)cur.pn * tstep + koff;
    S.a_ready(cur);
    if constexpr (SP2) {
        PG8_STAGE(PG8_SB(0, 0), cB, voffB); PG8_STAGE(PG8_SB(0, 1), cB + hstep, voffB); PG8_STAGE(PG8_SA(0, 0), cA, voffA); PG8_STAGE(PG8_SA(0, 1), cA + hstep, voffA);
        if (wr == 1) PG8_BAR;
        PG8_WAIT_V(2); PG8_BAR;
        PG8_STAGE(PG8_SB(1, 0), cB + kstep, voffB); PG8_STAGE(PG8_SA(1, 0), cA + kstep, voffA); PG8_STAGE(PG8_SB(1, 1), cB + hstep + kstep, voffB);
        PG8_WAIT_V(6); PG8_BAR;
    } else {
        PG8_STAGE(PG8_SB(0, 0), cB, voffB); PG8_STAGE(PG8_SA(0, 0), cA, voffA); PG8_STAGE(PG8_SB(0, 1), cB + hstep, voffB); PG8_STAGE(PG8_SA(0, 1), cA + hstep, voffA);
        if (wr == 1) PG8_BAR;
        PG8_WAIT_V(4); PG8_BAR;
        PG8_STAGE(PG8_SB(1, 0), cB + kstep, voffB); PG8_STAGE(PG8_SA(1, 0), cA + kstep, voffA); PG8_STAGE(PG8_SB(1, 1), cB + hstep + kstep, voffB);
        PG8_WAIT_V(6); PG8_BAR;
    }
    for (;;) {
        const bool has_next = S.next(ui + 1, nxt);
        const char* nA = has_next ? (const char*)g.A + (size_t)nxt.pm * tstep + koff : cA; const char* nB = has_next ? (const char*)g.Bt + (size_t)nxt.pn * tstep + koff : cB;
#pragma unroll 1
        for (int t = 0; t < nt; t += 2) {
            const bool last = (t == nt - 2);
            const char* a1 = cA + (size_t)(t + 1) * kstep;
            const char* a2 = last ? nA : cA + (size_t)(t + 2) * kstep; const char* b2 = last ? nB : cB + (size_t)(t + 2) * kstep;
            const char* a3 = a2 + kstep; const char* b3 = b2 + kstep;
            if (last && has_next) S.a_ready(nxt);
            if constexpr (SP2) {
            PG8_LDB(B0, 0, 0); PG8_LDB(B1, 0, 1); PG8_SCHED; PG8_LDA(At, 0, 0); PG8_STAGE(PG8_SA(1, 1), a1 + hstep, voffA);
            PG8_WAIT_V(8); PG8_WAIT_L(0); PG8_BAR; PG8_MMA(0, 0, At, B0); PG8_MMA(0, 1, At, B1); PG8_BAR; PG8_SCHED;
            PG8_LDA(At, 0, 1); PG8_STAGE(PG8_SB(0, 0), b2, voffB); PG8_STAGE(PG8_SB(0, 1), b2 + hstep, voffB); PG8_STAGE(PG8_SA(0, 0), a2, voffA);
            PG8_WAIT_V(8); PG8_WAIT_L(0); PG8_BAR; PG8_MMA(1, 0, At, B0); PG8_MMA(1, 1, At, B1); PG8_BAR; PG8_SCHED;
            PG8_LDB(B0, 1, 0); PG8_LDB(B1, 1, 1); PG8_SCHED; PG8_LDA(At, 1, 0); PG8_STAGE(PG8_SA(0, 1), a2 + hstep, voffA);
            PG8_WAIT_V(8); PG8_WAIT_L(0); PG8_BAR; PG8_MMA(0, 0, At, B0); PG8_MMA(0, 1, At, B1); PG8_BAR; PG8_SCHED;
            PG8_LDA(At, 1, 1); PG8_STAGE(PG8_SB(1, 0), b3, voffB); PG8_STAGE(PG8_SB(1, 1), b3 + hstep, voffB); PG8_STAGE(PG8_SA(1, 0), a3, voffA);
            PG8_WAIT_V(8); PG8_WAIT_L(0); PG8_BAR; PG8_MMA(1, 0, At, B0); PG8_MMA(1, 1, At, B1); PG8_BAR; PG8_SCHED;
            } else {
            PG8_LDB(B0, 0, 0); PG8_SCHED; PG8_LDA(At, 0, 0); PG8_STAGE(PG8_SA(1, 1), a1 + hstep, voffA);
            PG8_WAIT_L(8); PG8_BAR; PG8_WAIT_L(0); PG8_MMA(0, 0, At, B0); PG8_BAR; PG8_SCHED;
            PG8_LDB(B1, 0, 1); PG8_STAGE(PG8_SB(0, 0), b2, voffB);
            PG8_BAR; PG8_WAIT_L(0); PG8_MMA(0, 1, At, B1); PG8_BAR;
            PG8_LDA(At, 0, 1); PG8_STAGE(PG8_SA(0, 0), a2, voffA);
            PG8_BAR; PG8_WAIT_L(0); PG8_MMA(1, 0, At, B0); PG8_BAR; PG8_SCHED;
            PG8_STAGE(PG8_SB(0, 1), b2 + hstep, voffB);
            PG8_WAIT_V(6); PG8_BAR; PG8_MMA(1, 1, At, B1); PG8_BAR;
            PG8_LDB(B0, 1, 0); PG8_SCHED; PG8_LDA(At, 1, 0); PG8_STAGE(PG8_SA(0, 1), a2 + hstep, voffA);
            PG8_WAIT_L(8); PG8_BAR; PG8_WAIT_L(0); PG8_MMA(0, 0, At, B0); PG8_BAR; PG8_SCHED;
            PG8_LDB(B1, 1, 1); PG8_STAGE(PG8_SB(1, 0), b3, voffB);
            PG8_BAR; PG8_WAIT_L(0); PG8_MMA(0, 1, At, B1); PG8_BAR;
            PG8_LDA(At, 1, 1); PG8_STAGE(PG8_SA(1, 0), a3, voffA);
            PG8_BAR; PG8_WAIT_L(0); PG8_MMA(1, 0, At, B0); PG8_BAR; PG8_SCHED;
            PG8_STAGE(PG8_SB(1, 1), b3 + hstep, voffB);
            PG8_WAIT_V(6); PG8_BAR; PG8_MMA(1, 1, At, B1); PG8_BAR;
            }
        }
        if constexpr (ALIGN_EPI) { if (wr == 0) PG8_BAR; }
        if constexpr (!Epi::AFTER_DRAIN) { int laneE; asm volatile("v_mbcnt_lo_u32_b32 %0, -1, 0\n\tv_mbcnt_hi_u32_b32 %0, -1, %0" : "=v"(laneE)); const int frE = laneE & 15, fqE = laneE >> 4;
            E(acc, cur, wr, wc, frE, fqE); S.done(cur); }
        if (!has_next) break;
#pragma unroll
        for (int a = 0; a < 2; ++a)
#pragma unroll
            for (int b = 0; b < 2; ++b)
#pragma unroll
                for (int m = 0; m < 4; ++m)
#pragma unroll
                    for (int n = 0; n < 2; ++n) acc[a][b][m][n] = (f32x4){0.f, 0.f, 0.f, 0.f};
        cur = nxt; cA = nA; cB = nB; ++ui;
        if constexpr (ALIGN_EPI) { if (wr == 1) PG8_BAR; }
    }
    PG8_WAIT_V(0);
    if constexpr (!ALIGN_EPI) { if (wr == 0) PG8_BAR; }
    PG8_BAR;
    if constexpr (Epi::AFTER_DRAIN) { E.fused(acc, cur, wr, wc, fr, fq, lds, wid, lane); S.done(cur); }
#undef PG8_SA
#undef PG8_SB
#undef PG8_STAGE
#undef PG8_LDA
#undef PG8_LDB
#undef PG8_MMA
#undef PG8_WAIT_V
#undef PG8_WAIT_L
#undef PG8_BAR
#undef PG8_SCHED
}
}
namespace att {
#define ATT_LAS __attribute__((address_space(3)))
typedef float f32x16 __attribute__((ext_vector_type(16)));
typedef float f32x4 __attribute__((ext_vector_type(4)));
typedef short bf16x8 __attribute__((ext_vector_type(8)));
typedef short s16x4 __attribute__((ext_vector_type(4)));
typedef short v4i16_t __attribute__((ext_vector_type(4)));
typedef unsigned u32x4 __attribute__((ext_vector_type(4)));
typedef int i32x4q __attribute__((ext_vector_type(4)));
typedef int i32x8q __attribute__((ext_vector_type(8)));
typedef unsigned short bf16_t;
constexpr int PITCH = 1024;
constexpr float LOG2E = 1.4426950408889634f;
constexpr int L_K = 0, L_V = 49152, L_WSF = 81920, L_RPB = 81920 + 8 * 512, L_DMY = 81920 + 6144, L_QST = 81920 + 8192, L_NAV = 81920 + 8192, KBUF = 16384, VBUF = 16384;

__device__ __forceinline__ int crow(int r, int hi) { return (r & 3) + 8 * (r >> 2) + 4 * hi; }
__device__ __forceinline__ s16x4 vtr(const ATT_LAS char* p) { return __builtin_bit_cast(s16x4, __builtin_amdgcn_ds_read_tr16_b64_v4i16((ATT_LAS v4i16_t*)p)); }
__device__ __forceinline__ unsigned cvtpk(float lo, float hi) { unsigned r; asm volatile("v_cvt_pk_bf16_f32 %0, %1, %2" : "=v"(r) : "v"(lo), "v"(hi)); return r; }
__device__ __forceinline__ unsigned f2bf(float f) { unsigned u = __builtin_bit_cast(unsigned, f); return (u + 0x7fffu + ((u >> 16) & 1u)) >> 16; }
__device__ __forceinline__ void dma16(const void* g, ATT_LAS unsigned char* l) { unsigned keep; const unsigned dst = (unsigned)__builtin_amdgcn_readfirstlane((int)(unsigned)(uintptr_t)l);
    asm volatile("s_mov_b32 %0, m0\n\ts_mov_b32 m0, %2\n\ts_nop 0\n\tglobal_load_lds_dwordx4 %1, off\n\ts_mov_b32 m0, %0" : "=&s"(keep) : "v"(g), "s"(dst) : "memory"); }
#define ATT_LDSW() asm volatile("s_waitcnt lgkmcnt(0)" ::: "memory")
__device__ __forceinline__ void dma16s(const void* sbase, unsigned voff, ATT_LAS unsigned char* l) { unsigned keep; const unsigned dst = (unsigned)__builtin_amdgcn_readfirstlane((int)(unsigned)(uintptr_t)l);
    asm volatile("s_mov_b32 %0, m0\n\ts_mov_b32 m0, %3\n\ts_nop 0\n\tglobal_load_lds_dwordx4 %1, %2\n\ts_mov_b32 m0, %0" : "=&s"(keep) : "v"(voff), "s"(sbase), "s"(dst) : "memory"); }
using xl::swz_xor; using xl::half_max; using xl::half_sum;
#define ATT_IDS() int lane_l; asm volatile("v_mbcnt_lo_u32_b32 %0, -1, 0\n\tv_mbcnt_hi_u32_b32 %0, -1, %0" : "=v"(lane_l)); const int wid = wave_in, lane = lane_l, tid = wid * 64 + lane, r32 = lane & 31, hi = lane >> 5; (void)tid

__device__ __forceinline__ float max3f(float a, float b, float c) { float r; asm("v_max3_f32 %0, %1, %2, %3" : "=v"(r) : "v"(a), "v"(b), "v"(c)); return r; }
__device__ __forceinline__ float rowmax32(f32x16& p0, f32x16& p1) {
    asm volatile("s_nop 15\n\ts_nop 7" : "+v"(p0), "+v"(p1));
    float a = max3f(p0[0], p0[1], p1[0]), b = max3f(p0[2], p0[3], p1[1]); a = max3f(a, p1[2], p1[3]);
#pragma unroll
    for (int r = 4; r < 16; r += 4) { a = max3f(a, p0[r], p0[r + 1]); b = max3f(b, p0[r + 2], p0[r + 3]); a = max3f(a, p1[r], p1[r + 1]); b = max3f(b, p1[r + 2], p1[r + 3]); }
    float r; asm("v_max_f32_e32 %0, %1, %2" : "=v"(r) : "v"(a), "v"(b)); return r;
}
constexpr float SUM_BIG = 16777216.0f;
#define SM_EXPSUM8(P, Q, B, S) asm("v_exp_f32_e32 %0, %9\n\tv_exp_f32_e32 %1, %10\n\tv_exp_f32_e32 %2, %11\n\tv_add_f32_e32 %8, %0, %8\n\tv_exp_f32_e32 %3, %12\n\tv_add_f32_e32 %8, %1, %8\n\tv_exp_f32_e32 %4, %13\n\tv_add_f32_e32 %8, %2, %8\n\tv_exp_f32_e32 %5, %14\n\tv_add_f32_e32 %8, %3, %8\n\tv_exp_f32_e32 %6, %15\n\tv_add_f32_e32 %8, %4, %8\n\tv_exp_f32_e32 %7, %16\n\tv_add_f32_e32 %8, %5, %8\n\tv_add_f32_e32 %8, %6, %8\n\tv_add_f32_e32 %8, %7, %8" \
        : "=&v"(P[B]), "=&v"(P[B + 1]), "=&v"(P[B + 2]), "=&v"(P[B + 3]), "=&v"(P[B + 4]), "=&v"(P[B + 5]), "=&v"(P[B + 6]), "=&v"(P[B + 7]), "+v"(S) \
        : "v"(Q[B]), "v"(Q[B + 1]), "v"(Q[B + 2]), "v"(Q[B + 3]), "v"(Q[B + 4]), "v"(Q[B + 5]), "v"(Q[B + 6]), "v"(Q[B + 7]))
__device__ __forceinline__ bool softmax_fast(f32x16& p0, f32x16& p1, float& l, u32x4 (&pa)[4]) {
    asm volatile("s_nop 15\n\ts_nop 7" : "+v"(p0), "+v"(p1));
    float a[16], b[16]; float s = 0.f;
    SM_EXPSUM8(a, p0, 0, s); SM_EXPSUM8(a, p0, 8, s); SM_EXPSUM8(b, p1, 0, s); SM_EXPSUM8(b, p1, 8, s);
    if (__any(!(s < SUM_BIG))) return false;
    l += s;
    pa[0] = (u32x4){cvtpk(a[0], a[1]), cvtpk(a[2], a[3]), cvtpk(a[4], a[5]), cvtpk(a[6], a[7])};
    pa[1] = (u32x4){cvtpk(a[8], a[9]), cvtpk(a[10], a[11]), cvtpk(a[12], a[13]), cvtpk(a[14], a[15])};
    pa[2] = (u32x4){cvtpk(b[0], b[1]), cvtpk(b[2], b[3]), cvtpk(b[4], b[5]), cvtpk(b[6], b[7])};
    pa[3] = (u32x4){cvtpk(b[8], b[9]), cvtpk(b[10], b[11]), cvtpk(b[12], b[13]), cvtpk(b[14], b[15])};
    return true;
}
#define NA_KFRAG(kb) __builtin_shufflevector(*(const ATT_LAS i32x4q*)(kb), *(const ATT_LAS i32x4q*)((kb) + 1024), 0, 1, 2, 3, 4, 5, 6, 7)
__device__ __forceinline__ f32x16 mfma_qk8(const i32x8q k, const i32x8q q, const f32x16 c) { return __builtin_amdgcn_mfma_scale_f32_32x32x64_f8f6f4(k, q, c, 0, 0, 0, 0x7f7f7f7f, 0, 0x7c7c7c7c); }
constexpr float RESC_THR = 8.0f;
struct NoMask { __device__ __forceinline__ void operator()(f32x16&, f32x16&) const {} };
__host__ __device__ constexpr unsigned long long na_lane_mask(int r, int half, int c0) {
    unsigned long long mk = 0;
    for (int lane = 0; lane < 64; ++lane) { const int hi = lane >> 5, c = c0 + (lane & 31), kc = (r & 3) + 8 * (r >> 2) + 4 * hi + 32 * half;
        int ws = c - 8; ws = ws < 0 ? 0 : (ws > 48 ? 48 : ws);
        if (kc >= ws && kc < ws + 16) mk |= 1ull << lane; }
    return mk;
}
__device__ __forceinline__ float sel_mask(float v, unsigned long long mk) { float r; asm("v_cndmask_b32_e64 %0, %1, %2, %3" : "=v"(r) : "v"(-INFINITY), "v"(v), "s"(mk)); return r; }
struct NaMask {
    const ATT_LAS float* lbase; int c0;
    __device__ __forceinline__ void operator()(f32x16& p0, f32x16& p1) const {
        asm volatile("s_nop 15\n\ts_nop 7" : "+v"(p0), "+v"(p1));
#pragma unroll
        for (int r = 0; r < 16; ++r) {
            const int e = (r & 3) + 8 * (r >> 2);
            const float b0 = lbase[e], b1 = lbase[e + 32];
            const unsigned long long m0 = c0 ? na_lane_mask(r, 0, 32) : na_lane_mask(r, 0, 0), m1 = c0 ? na_lane_mask(r, 1, 32) : na_lane_mask(r, 1, 0);
            p0[r] = sel_mask(p0[r] + b0, m0);
            p1[r] = sel_mask(p1[r] + b1, m1);
        }
    }
};

template <int NDB, class Mask>
__device__ __forceinline__ void qk_step(const ATT_LAS unsigned char* Kimg, const i32x8q& qf, float& m, float& l, f32x16 (&o)[NDB], u32x4 (&pa)[4], ATT_LAS float* wsf, const Mask& mask, int r32, int hi) {
    f32x16 p0, p1;
#pragma unroll
    for (int r = 0; r < 16; ++r) { p0[r] = 0.f; p1[r] = 0.f; }
    const ATT_LAS unsigned char* kb = Kimg + hi * 2048 + r32 * 16;
    { const i32x8q k0 = NA_KFRAG(kb), k1 = NA_KFRAG(kb + 512); const f32x16 z = p0; p0 = mfma_qk8(k0, qf, z); p1 = mfma_qk8(k1, qf, z); }
    mask(p0, p1);
    float mx = rowmax32(p0, p1);
    mx = half_max(mx);
    const float mn = fmaxf(m, mx);
    if (__any(mx > m + RESC_THR)) {
        const float alpha = __builtin_amdgcn_exp2f(m - mn);
        l *= alpha; m = mn;
        int le_; asm volatile("v_mbcnt_lo_u32_b32 %0, -1, 0\n\tv_mbcnt_hi_u32_b32 %0, -1, %0" : "=v"(le_)); const int hi_ = le_ >> 5;
        if (le_ < 32) wsf[le_] = alpha;
        ATT_LDSW();
#pragma unroll
        for (int g = 0; g < 4; ++g) { const f32x4 a4 = *(const ATT_LAS f32x4*)(wsf + 8 * g + 4 * hi_);
#pragma unroll
            for (int db = 0; db < NDB; ++db) { o[db][4 * g] *= a4[0]; o[db][4 * g + 1] *= a4[1]; o[db][4 * g + 2] *= a4[2]; o[db][4 * g + 3] *= a4[3]; } }
        ATT_LDSW();
    }
    float s = 0.f;
#pragma unroll
    for (int r = 0; r < 16; ++r) { p0[r] = __builtin_amdgcn_exp2f(p0[r] - m); p1[r] = __builtin_amdgcn_exp2f(p1[r] - m); s += p0[r] + p1[r]; }
    l += s;
    pa[0] = (u32x4){cvtpk(p0[0], p0[1]), cvtpk(p0[2], p0[3]), cvtpk(p0[4], p0[5]), cvtpk(p0[6], p0[7])};
    pa[1] = (u32x4){cvtpk(p0[8], p0[9]), cvtpk(p0[10], p0[11]), cvtpk(p0[12], p0[13]), cvtpk(p0[14], p0[15])};
    pa[2] = (u32x4){cvtpk(p1[0], p1[1]), cvtpk(p1[2], p1[3]), cvtpk(p1[4], p1[5]), cvtpk(p1[6], p1[7])};
    pa[3] = (u32x4){cvtpk(p1[8], p1[9]), cvtpk(p1[10], p1[11]), cvtpk(p1[12], p1[13]), cvtpk(p1[14], p1[15])};
}
__host__ __device__ constexpr unsigned long long na_lane_mask2(int r, int cls) {
    unsigned long long mk = 0;
    for (int lane = 0; lane < 64; ++lane) { const int hi = lane >> 5, j = lane & 15, cr = (r & 3) + 8 * (r >> 2) + 4 * hi;
        int lo = 0;
        if (cls == 0) lo = (j - 8 < 0) ? 0 : j - 8; else if (cls == 1) lo = j; else lo = (8 + j > 16) ? 16 : 8 + j;
        if (cr >= lo && cr < lo + 16) mk |= 1ull << lane; }
    return mk;
}
__device__ __forceinline__ float rowmax16(f32x16& p0) {
    float a = max3f(p0[0], p0[1], p0[2]), b = max3f(p0[3], p0[4], p0[5]);
    a = max3f(a, p0[6], p0[7]); b = max3f(b, p0[8], p0[9]); a = max3f(a, p0[10], p0[11]); b = max3f(b, p0[12], p0[13]); a = max3f(a, p0[14], p0[15]);
    float r; asm("v_max_f32_e32 %0, %1, %2" : "=v"(r) : "v"(a), "v"(b)); return r;
}
template <int CLS>
__device__ __forceinline__ void qk_step1(const ATT_LAS unsigned char* Kblk, const i32x8q& qf, float& m, float& l, f32x16 (&o)[2], u32x4 (&pa)[2], ATT_LAS float* wsf, const ATT_LAS float* lbase, int r32, int hi) {
    f32x16 p0;
#pragma unroll
    for (int r = 0; r < 16; ++r) p0[r] = 0.f;
    const ATT_LAS unsigned char* kb = Kblk + hi * 2048 + r32 * 16;
    { const i32x8q k0 = NA_KFRAG(kb); const f32x16 z = p0; p0 = mfma_qk8(k0, qf, z); }
    asm volatile("s_nop 15\n\ts_nop 7" : "+v"(p0));
#pragma unroll
    for (int r = 0; r < 16; ++r) p0[r] = sel_mask(p0[r] + lbase[(r & 3) + 8 * (r >> 2)], na_lane_mask2(r, CLS));
    float mx = rowmax16(p0);
    mx = half_max(mx);
    const float mn = fmaxf(m, mx);
    if (__any(mx > m + RESC_THR)) {
        const float alpha = __builtin_amdgcn_exp2f(m - mn);
        l *= alpha; m = mn;
        int le_; asm volatile("v_mbcnt_lo_u32_b32 %0, -1, 0\n\tv_mbcnt_hi_u32_b32 %0, -1, %0" : "=v"(le_)); const int hi_ = le_ >> 5;
        if (le_ < 32) wsf[le_] = alpha;
        ATT_LDSW();
#pragma unroll
        for (int g = 0; g < 4; ++g) { const f32x4 a4 = *(const ATT_LAS f32x4*)(wsf + 8 * g + 4 * hi_);
#pragma unroll
            for (int db = 0; db < 2; ++db) { o[db][4 * g] *= a4[0]; o[db][4 * g + 1] *= a4[1]; o[db][4 * g + 2] *= a4[2]; o[db][4 * g + 3] *= a4[3]; } }
        ATT_LDSW();
    }
    float s = 0.f;
#pragma unroll
    for (int r = 0; r < 16; ++r) { p0[r] = __builtin_amdgcn_exp2f(p0[r] - m); s += p0[r]; }
    l += s;
    pa[0] = (u32x4){cvtpk(p0[0], p0[1]), cvtpk(p0[2], p0[3]), cvtpk(p0[4], p0[5]), cvtpk(p0[6], p0[7])};
    pa[1] = (u32x4){cvtpk(p0[8], p0[9]), cvtpk(p0[10], p0[11]), cvtpk(p0[12], p0[13]), cvtpk(p0[14], p0[15])};
}
__device__ __forceinline__ bf16x8 vfrag(const ATT_LAS unsigned char* p) { const s16x4 lo = vtr((const ATT_LAS char*)p), hi4 = vtr((const ATT_LAS char*)p + 512); return (bf16x8){lo[0], lo[1], lo[2], lo[3], hi4[0], hi4[1], hi4[2], hi4[3]}; }

#define ATT_BAR() do { asm volatile("s_waitcnt lgkmcnt(0)" ::: "memory"); __builtin_amdgcn_s_barrier(); asm volatile("" ::: "memory"); } while (0)
template <int CLS>
__device__ __forceinline__ bool na_fast1(const ATT_LAS unsigned char* kb, const i32x8q& qf, const f32x16& negm, float& l, u32x4 (&pa)[2], const ATT_LAS float* lbase) {
    float bz[16];
#pragma unroll
    for (int r = 0; r < 16; ++r) bz[r] = lbase[(r & 3) + 8 * (r >> 2)];
    f32x16 p0 = mfma_qk8(NA_KFRAG(kb), qf, negm);
    asm volatile("s_nop 15\n\ts_nop 7" : "+v"(p0) : "v"(bz[0]), "v"(bz[1]), "v"(bz[2]), "v"(bz[3]), "v"(bz[4]), "v"(bz[5]), "v"(bz[6]), "v"(bz[7]), "v"(bz[8]), "v"(bz[9]), "v"(bz[10]), "v"(bz[11]), "v"(bz[12]), "v"(bz[13]), "v"(bz[14]), "v"(bz[15]));
    float t[16], a[16]; float s = 0.f;
#pragma unroll
    for (int r = 0; r < 16; ++r) t[r] = sel_mask(p0[r] + bz[r], na_lane_mask2(r, CLS));
    SM_EXPSUM8(a, t, 0, s); SM_EXPSUM8(a, t, 8, s);
    if (__any(!(s < SUM_BIG))) return false;
    l += s;
    pa[0] = (u32x4){cvtpk(a[0], a[1]), cvtpk(a[2], a[3]), cvtpk(a[4], a[5]), cvtpk(a[6], a[7])};
    pa[1] = (u32x4){cvtpk(a[8], a[9]), cvtpk(a[10], a[11]), cvtpk(a[12], a[13]), cvtpk(a[14], a[15])};
    return true;
}
__device__ __forceinline__ bool ctx_fast(const ATT_LAS unsigned char* kb, const i32x8q& qf, const f32x16& negm, float& l, u32x4 (&pa)[4]) {
    i32x8q k0 = NA_KFRAG(kb), k1 = NA_KFRAG(kb + 512);
    asm volatile("" : "+v"(k0), "+v"(k1));
    f32x16 p0 = mfma_qk8(k0, qf, negm), p1 = mfma_qk8(k1, qf, negm);
    return softmax_fast(p0, p1, l, pa);
}
#define NA_VRD(i, addr, off) asm volatile("ds_read_b64_tr_b16 %0, %2 offset:%3\n\tds_read_b64_tr_b16 %1, %2 offset:%4" : "=&v"(vl[i]), "=&v"(vh[i]) : "v"(addr), "n"(off), "n"((off) + 512) : "memory")
#define NA_VFRAG(i) ((bf16x8){vl[i][0], vl[i][1], vl[i][2], vl[i][3], vh[i][0], vh[i][1], vh[i][2], vh[i][3]})
__device__ __forceinline__ void na_unit(int b, int h, int rg, const unsigned char* Q, const unsigned char* K, const bf16_t* V, bf16_t* O, const float* rpb, ATT_LAS unsigned char* lds, int wave_in) {
    ATT_IDS();
    const bool latq = rg < 8;
    int r0 = 0, cg = 0, rsA = 0, rsB = 0, kbase = 0, kr_lo = 0, n_lat = 0, qrow;
    if (latq) { r0 = 4 * rg + 2 * (wid >> 2); cg = wid & 3; rsA = r0 - 4; rsA = rsA < 0 ? 0 : (rsA > 24 ? 24 : rsA); rsB = r0 + 1 - 4; rsB = rsB < 0 ? 0 : (rsB > 24 ? 24 : rsB);
        kbase = 16 * cg - 8; kbase = kbase < 0 ? 0 : (kbase > 32 ? 32 : kbase);
        kr_lo = 4 * rg - 4; kr_lo = kr_lo < 0 ? 0 : (kr_lo > 24 ? 24 : kr_lo); int kh = 4 * rg + 3 - 4; kh = kh < 0 ? 0 : (kh > 24 ? 24 : kh); n_lat = kh + 7 - kr_lo + 1;
        qrow = b * 2048 + r0 * 64 + 16 * cg; }
    else qrow = 32768 + b * 256 + wid * 32;
    const int qoff = latq ? ((r32 >> 4) * 64 + (r32 & 15)) : r32;
    const int NT = n_lat + 4;
    ATT_LAS float* wsf = (ATT_LAS float*)(lds + L_WSF) + wid * 128;
    ATT_LAS float* rpbL = (ATT_LAS float*)(lds + L_RPB) + 64;
    __syncthreads();
    ATT_LAS float* ninfL = rpbL + 800;
    if (latq && tid < 465) rpbL[(tid / 31) * 48 + tid % 31] = rpb[h * 465 + tid] * LOG2E;
    if (latq && tid >= 480) ninfL[tid - 480] = -INFINITY;
    const unsigned kvo = (unsigned)(lane * PITCH + h * 64 + (wid & 3) * 16), vvo = (unsigned)(((16 * (wid & 3) + (lane >> 2)) * PITCH + h * 64 + (wid >> 2) * 32 + (lane & 3) * 8) * 2);
#define NA_TROW(t) ((t) < n_lat ? b * 2048 + (kr_lo + (t)) * 64 : 32768 + b * 256 + ((t) - n_lat) * 64)
#define NA_DMA(t, bo) do { const size_t ro_ = (size_t)NA_TROW(t) * PITCH; \
        dma16s((const char*)K + ro_, kvo, lds + L_K + (bo) + (wid & 3) * 1024); dma16s((const char*)V + ro_ * 2, vvo, lds + L_NAV + (bo) + wid * 1024); } while (0)
    NA_DMA(0, 0); NA_DMA(1, 8192); NA_DMA(2, 16384); NA_DMA(3, 24576);
    if (NT > 4) NA_DMA(4, 32768);
    i32x8q qf; { const unsigned char* qp = Q + (size_t)(qrow + qoff) * PITCH + h * 64 + hi * 32; qf = __builtin_shufflevector(*(const i32x4q*)(qp), *(const i32x4q*)(qp + 16), 0, 1, 2, 3, 4, 5, 6, 7); }
    asm volatile("" : "+v"(qf));
    float m = -1e30f, l = 0.f; f32x16 o[2], negm;
#pragma unroll
    for (int i = 0; i < 16; ++i) { o[0][i] = 0.f; o[1][i] = 0.f; negm[i] = 0.f; }
    bool first = true;
    const int vb = ((lane >> 4) & 1) * 32 + (lane & 3) * 8 + (4 * hi + ((lane & 15) >> 2)) * 64;
    const int cq = 16 * cg + (r32 & 15), rq = r0 + (r32 >> 4);
    int b0 = 0, b5 = 40960;
    for (int t = 0; t < NT; ++t) {
        { const int fl = NT - 1 - t;
          if (fl >= 4) asm volatile("s_waitcnt vmcnt(8)" ::: "memory"); else if (fl == 3) asm volatile("s_waitcnt vmcnt(6)" ::: "memory"); else if (fl == 2) asm volatile("s_waitcnt vmcnt(4)" ::: "memory");
          else if (fl == 1) asm volatile("s_waitcnt vmcnt(2)" ::: "memory"); else asm volatile("s_waitcnt vmcnt(0)" ::: "memory"); }
        ATT_BAR();
        if (t + 5 < NT) NA_DMA(t + 5, b5);
        bool mine = true; int kr = 0;
        if (t < n_lat) { kr = kr_lo + t; mine = (kr >= rsA) && (kr <= rsB + 7); }
        if (mine) {
            const ATT_LAS unsigned char* Kimg = lds + L_K + b0; const ATT_LAS unsigned char* Vimg = lds + L_NAV + b0;
            if (t < n_lat) {
                const bool rowok = (r32 >> 4) ? (kr >= rsB) : (kr <= rsA + 7);
                const ATT_LAS float* lb = rowok ? rpbL + (kr - rq + 7) * 48 + (kbase - cq + 15 + 4 * hi) : ninfL;
                s16x4 vl[4], vh[4]; { const unsigned va = (unsigned)(uintptr_t)(Vimg + vb + kbase * 64); NA_VRD(0, va, 0); NA_VRD(1, va, 4096); NA_VRD(2, va, 1024); NA_VRD(3, va, 4096 + 1024); }
                u32x4 pa[2]; bool ok = false;
                const ATT_LAS unsigned char* kbf = Kimg + kbase * 16 + hi * 2048 + r32 * 16;
                if (!first) { if (cg == 0) ok = na_fast1<0>(kbf, qf, negm, l, pa, lb); else if (cg == 3) ok = na_fast1<2>(kbf, qf, negm, l, pa, lb); else ok = na_fast1<1>(kbf, qf, negm, l, pa, lb); }
                if (__builtin_expect(!ok, 0)) {
                    if (cg == 0) qk_step1<0>(Kimg + kbase * 16, qf, m, l, o, pa, wsf, lb, r32, hi); else if (cg == 3) qk_step1<2>(Kimg + kbase * 16, qf, m, l, o, pa, wsf, lb, r32, hi); else qk_step1<1>(Kimg + kbase * 16, qf, m, l, o, pa, wsf, lb, r32, hi);
#pragma unroll
                    for (int i = 0; i < 16; ++i) negm[i] = -m;
                    first = false; }
                asm volatile("s_waitcnt lgkmcnt(0)" : "+v"(vl[0]), "+v"(vh[0]), "+v"(vl[1]), "+v"(vh[1]), "+v"(vl[2]), "+v"(vh[2]), "+v"(vl[3]), "+v"(vh[3]) :: "memory");
                o[0] = __builtin_amdgcn_mfma_f32_32x32x16_bf16(__builtin_bit_cast(bf16x8, pa[0]), NA_VFRAG(0), o[0], 0, 0, 0); o[1] = __builtin_amdgcn_mfma_f32_32x32x16_bf16(__builtin_bit_cast(bf16x8, pa[0]), NA_VFRAG(1), o[1], 0, 0, 0);
                o[0] = __builtin_amdgcn_mfma_f32_32x32x16_bf16(__builtin_bit_cast(bf16x8, pa[1]), NA_VFRAG(2), o[0], 0, 0, 0); o[1] = __builtin_amdgcn_mfma_f32_32x32x16_bf16(__builtin_bit_cast(bf16x8, pa[1]), NA_VFRAG(3), o[1], 0, 0, 0);
            } else {
                s16x4 vl[8], vh[8]; { const unsigned va = (unsigned)(uintptr_t)(Vimg + vb); NA_VRD(0, va, 0); NA_VRD(1, va, 4096); NA_VRD(2, va, 1024); NA_VRD(3, va, 4096 + 1024); NA_VRD(4, va, 2048); NA_VRD(5, va, 4096 + 2048); NA_VRD(6, va, 3072); NA_VRD(7, va, 4096 + 3072); }
                u32x4 pa[4]; bool ok = false;
                if (!first) ok = ctx_fast(Kimg + hi * 2048 + r32 * 16, qf, negm, l, pa);
                if (__builtin_expect(!ok, 0)) { NoMask mk; qk_step<2>(Kimg, qf, m, l, o, pa, wsf, mk, r32, hi);
#pragma unroll
                    for (int i = 0; i < 16; ++i) negm[i] = -m;
                    first = false; }
                asm volatile("s_waitcnt lgkmcnt(0)" : "+v"(vl[0]), "+v"(vh[0]), "+v"(vl[1]), "+v"(vh[1]), "+v"(vl[2]), "+v"(vh[2]), "+v"(vl[3]), "+v"(vh[3]), "+v"(vl[4]), "+v"(vh[4]), "+v"(vl[5]), "+v"(vh[5]), "+v"(vl[6]), "+v"(vh[6]), "+v"(vl[7]), "+v"(vh[7]) :: "memory");
#pragma unroll
                for (int ks = 0; ks < 4; ++ks) { o[0] = __builtin_amdgcn_mfma_f32_32x32x16_bf16(__builtin_bit_cast(bf16x8, pa[ks]), NA_VFRAG(2 * ks), o[0], 0, 0, 0);
                    o[1] = __builtin_amdgcn_mfma_f32_32x32x16_bf16(__builtin_bit_cast(bf16x8, pa[ks]), NA_VFRAG(2 * ks + 1), o[1], 0, 0, 0); }
            }
        }
        b0 = (b0 == 40960) ? 0 : b0 + 8192; b5 = (b5 == 40960) ? 0 : b5 + 8192;
    }
#undef NA_DMA
#undef NA_TROW
#undef NA_VRD
#undef NA_VFRAG
    l = half_sum(l);
    if (hi == 0) wsf[r32] = __builtin_amdgcn_rcpf(l);
    ATT_LDSW();
    bf16_t* Ow = O + (size_t)qrow * PITCH + h * 64;
#pragma unroll
    for (int g = 0; g < 4; ++g) { const f32x4 a4 = *(const ATT_LAS f32x4*)(wsf + 8 * g + 4 * hi);
#pragma unroll
        for (int j = 0; j < 4; ++j) { const int q = (latq ? (g >> 1) * 64 + 8 * (g & 1) : 8 * g) + 4 * hi + j;
#pragma unroll
            for (int db = 0; db < 2; ++db) Ow[(size_t)q * PITCH + db * 32 + r32] = (bf16_t)f2bf(o[db][4 * g + j] * a4[j]); } }
    ATT_LDSW();
}

template <int NDB>
__device__ __forceinline__ void softmax_step(f32x16& p0, f32x16& p1, float& m, float& l, f32x16 (&o)[NDB], u32x4 (&pa)[4], ATT_LAS float* wsf, int r32, int hi) {
    float mx = rowmax32(p0, p1);
    mx = half_max(mx);
    const float mn = fmaxf(m, mx);
    if (__any(mx > m + RESC_THR)) {
        const float alpha = __builtin_amdgcn_exp2f(m - mn);
        l *= alpha; m = mn;
        int le_; asm volatile("v_mbcnt_lo_u32_b32 %0, -1, 0\n\tv_mbcnt_hi_u32_b32 %0, -1, %0" : "=v"(le_)); const int hi_ = le_ >> 5;
        if (le_ < 32) wsf[le_] = alpha;
        ATT_LDSW();
#pragma unroll
        for (int g = 0; g < 4; ++g) { const f32x4 a4 = *(const ATT_LAS f32x4*)(wsf + 8 * g + 4 * hi_);
#pragma unroll
            for (int db = 0; db < NDB; ++db) { o[db][4 * g] *= a4[0]; o[db][4 * g + 1] *= a4[1]; o[db][4 * g + 2] *= a4[2]; o[db][4 * g + 3] *= a4[3]; } }
        ATT_LDSW();
    }
    float s = 0.f;
#pragma unroll
    for (int r = 0; r < 16; ++r) { p0[r] = __builtin_amdgcn_exp2f(p0[r] - m); p1[r] = __builtin_amdgcn_exp2f(p1[r] - m); s += p0[r] + p1[r]; }
    l += s;
    pa[0] = (u32x4){cvtpk(p0[0], p0[1]), cvtpk(p0[2], p0[3]), cvtpk(p0[4], p0[5]), cvtpk(p0[6], p0[7])};
    pa[1] = (u32x4){cvtpk(p0[8], p0[9]), cvtpk(p0[10], p0[11]), cvtpk(p0[12], p0[13]), cvtpk(p0[14], p0[15])};
    pa[2] = (u32x4){cvtpk(p1[0], p1[1]), cvtpk(p1[2], p1[3]), cvtpk(p1[4], p1[5]), cvtpk(p1[6], p1[7])};
    pa[3] = (u32x4){cvtpk(p1[8], p1[9]), cvtpk(p1[10], p1[11]), cvtpk(p1[12], p1[13]), cvtpk(p1[14], p1[15])};
}
__device__ __forceinline__ int pk2f8(float a, float b, int old, bool hiw) { return hiw ? __builtin_amdgcn_cvt_pk_fp8_f32(a, b, old, true) : __builtin_amdgcn_cvt_pk_fp8_f32(a, b, old, false); }
#define SM_PACK8(A, B) ((i32x8q){pk2f8(A[2], A[3], pk2f8(A[0], A[1], 0, false), true), pk2f8(A[6], A[7], pk2f8(A[4], A[5], 0, false), true), pk2f8(A[10], A[11], pk2f8(A[8], A[9], 0, false), true), pk2f8(A[14], A[15], pk2f8(A[12], A[13], 0, false), true), \
                               pk2f8(B[2], B[3], pk2f8(B[0], B[1], 0, false), true), pk2f8(B[6], B[7], pk2f8(B[4], B[5], 0, false), true), pk2f8(B[10], B[11], pk2f8(B[8], B[9], 0, false), true), pk2f8(B[14], B[15], pk2f8(B[12], B[13], 0, false), true)})
constexpr float SUM_BIG8 = 256.0f;
#define SM_PK4(E, I) pk2f8(E[(I) + 2], E[(I) + 3], pk2f8(E[(I)], E[(I) + 1], 0, false), true)
__device__ __forceinline__ bool softmax_fast8(f32x16& p0, f32x16& p1, float& l, i32x8q& pq) {
    asm volatile("s_nop 15\n\ts_nop 7" : "+v"(p0), "+v"(p1));
    float s = 0.f;
    { float e[16]; SM_EXPSUM8(e, p0, 0, s); pq[0] = SM_PK4(e, 0); pq[1] = SM_PK4(e, 4); }
    { float e[16]; SM_EXPSUM8(e, p0, 8, s); pq[2] = SM_PK4(e, 8); pq[3] = SM_PK4(e, 12); }
    { float e[16]; SM_EXPSUM8(e, p1, 0, s); pq[4] = SM_PK4(e, 0); pq[5] = SM_PK4(e, 4); }
    { float e[16]; SM_EXPSUM8(e, p1, 8, s); pq[6] = SM_PK4(e, 8); pq[7] = SM_PK4(e, 12); }
    if (__any(!(s < SUM_BIG8))) return false;
    l += s;
    return true;
}
__device__ __forceinline__ void softmax_step8(f32x16& p0, f32x16& p1, float& m, float& l, f32x16 (&o)[4], i32x8q& pq, ATT_LAS f32x4* nme) {
    float mx = rowmax32(p0, p1);
    mx = half_max(mx);
    const float mn = fmaxf(m, mx);
    if (__any(mx > m + RESC_THR)) {
        const float alpha = __builtin_amdgcn_exp2f(m - mn);
        l *= alpha; m = mn;
        *nme = (f32x4){-mn, -mn, -mn, -mn};
#pragma unroll
        for (int db = 0; db < 4; ++db)
#pragma unroll
            for (int i = 0; i < 16; ++i) o[db][i] *= alpha;
    }
    float s = 0.f;
#pragma unroll
    for (int r = 0; r < 16; ++r) { p0[r] = __builtin_amdgcn_exp2f(p0[r] - m); p1[r] = __builtin_amdgcn_exp2f(p1[r] - m); s += p0[r] + p1[r]; }
    l += s;
    pq = SM_PACK8(p0, p1);
}
#define ATT_VMW() asm volatile("s_waitcnt vmcnt(0)" ::: "memory")
template <int XM = 0>
__device__ __forceinline__ void diff_unit(int b, int hd, int qb, const unsigned char* Q, const unsigned char* K, const unsigned char* V, bf16_t* O, float lam, float outscale, const float* subln, ATT_LAS unsigned char* lds, int wave_in) {
    ATT_IDS();
    int grp; asm volatile("s_lshr_b32 %0, %1, 2" : "=s"(grp) : "s"(wid) : "scc");
    constexpr bool X_DMA = (XM != 2 && XM < 6), X_SM = (XM == 0 || XM == 2 || XM == 4 || XM == 5 || XM == 6 || XM == 10), X_QK2 = (XM == 0 || XM == 2 || XM == 3 || XM == 4 || XM == 6 || XM == 11),
                   X_PV = (XM == 0 || XM == 2 || XM == 3 || XM == 5 || XM == 7 || XM == 8), X_QK1 = (XM == 0 || XM == 2 || XM == 3 || XM == 4 || XM == 7 || XM == 9);
    const int qrow = b * 2048 + qb * 256 + wid * 32;
    constexpr int NT = 36;
    ATT_LAS float* wsf = (ATT_LAS float*)(lds + L_WSF) + wid * 128;
    __syncthreads();
#define DF_OFFS() int ld_; asm volatile("v_mbcnt_lo_u32_b32 %0, -1, 0\n\tv_mbcnt_hi_u32_b32 %0, -1, %0" : "=v"(ld_)); \
        const unsigned kvo = (unsigned)((16 * (wid & 3) + (ld_ >> 2)) * PITCH + hd * 128 + 64 * ((wid >> 2) & 1) + 16 * ((ld_ & 3) ^ ((ld_ >> 4) & 3))), \
                       vvo = (unsigned)((16 * wid + (ld_ >> 2)) * 2304 + 16 * ((ld_ & 3) ^ ((ld_ >> 4) & 3))); (void)kvo; (void)vvo
#define DF_TROW(t) ((t) < 32 ? b * 2048 + (t) * 64 : 32768 + b * 256 + ((t) - 32) * 64)
#define DF_DMA_K(t, kbo) do { DF_OFFS(); const char* kb_ = (const char*)K + (size_t)DF_TROW(t) * PITCH;     \
        dma16s(kb_, kvo, lds + L_K + (kbo) + wid * 1024); } while (0)
#define DF_DMA_V(t) do { DF_OFFS(); const char* vb_ = (const char*)V + (size_t)((b * 8 + hd) * 128) * 2304 + (t) * 64; const int bo_ = ((t) & 3);     \
        dma16s(vb_, vvo, lds + L_V + bo_ * 8192 + wid * 1024); } while (0)
    DF_DMA_K(0, 0); DF_DMA_K(1, KBUF); DF_DMA_V(0); DF_DMA_V(1);
    ATT_LAS unsigned char* qst = lds + L_QST + wid * 8192;
#pragma unroll
    for (int d0 = 0; d0 < 4; ++d0) *(ATT_LAS u32x4*)(qst + d0 * 1024 + lane * 16) = *(const u32x4*)(Q + (size_t)(qrow + r32) * PITCH + hd * 128 + (d0 >> 1) * 64 + hi * 32 + (d0 & 1) * 16);
    *(ATT_LAS f32x4*)(qst + 4096 + lane * 16) = (f32x4){0.f, 0.f, 0.f, 0.f}; *(ATT_LAS f32x4*)(qst + 4096 + 1024 + lane * 16) = (f32x4){0.f, 0.f, 0.f, 0.f};
    float m1 = -1e30f, l1 = 0.f, m2 = -1e30f, l2 = 0.f; f32x16 o1[4], o2[4];
#pragma unroll
    for (int db = 0; db < 4; ++db)
#pragma unroll
        for (int i = 0; i < 16; ++i) { o1[db][i] = 0.f; o2[db][i] = 0.f; }
    const int vb = ((lane >> 4) & 1) * 32 + (lane & 3) * 8 + (4 * hi + ((lane & 15) >> 2)) * 64;
    const int kfe = r32 * 64 + (((2 * hi) ^ ((r32 >> 2) & 3)) * 16);
    f32x16 sa, sb, sc2, sd2;
    i32x8q pq1, pq2;
#define DF_QKX(kbo, SUB, RAW, SA_, SB_) do { int kfo_ = kfe; asm volatile("v_xor_b32 %0, 16, %0" : "+v"(kfo_));     \
        const ATT_LAS unsigned char* kbe_ = lds + L_K + (kbo) + (SUB) * 4096 + kfe; const ATT_LAS unsigned char* kbo_ = lds + L_K + (kbo) + (SUB) * 4096 + kfo_; \
        i32x4q ql_ = *(const ATT_LAS i32x4q*)(qst + ((SUB) * 2) * 1024 + lane * 16), qh_ = *(const ATT_LAS i32x4q*)(qst + ((SUB) * 2 + 1) * 1024 + lane * 16); \
        i32x4q k0l_ = *(const ATT_LAS i32x4q*)(kbe_), k0h_ = *(const ATT_LAS i32x4q*)(kbo_), k1l_ = *(const ATT_LAS i32x4q*)(kbe_ + 2048), k1h_ = *(const ATT_LAS i32x4q*)(kbo_ + 2048); \
        f32x16 cin_; \
        if (RAW) { _Pragma("unroll") for (int r_ = 0; r_ < 16; ++r_) cin_[r_] = 0.f; } \
        else { const volatile ATT_LAS f32x4* ne_ = (const volatile ATT_LAS f32x4*)(qst + 4096 + (SUB) * 1024 + lane * 16);     \
            const f32x4 c0_ = *ne_, c1_ = *ne_, c2_ = *ne_, c3_ = *ne_; \
            cin_ = __builtin_shufflevector(__builtin_shufflevector(c0_, c1_, 0, 1, 2, 3, 4, 5, 6, 7), __builtin_shufflevector(c2_, c3_, 0, 1, 2, 3, 4, 5, 6, 7), 0, 1, 2, 3, 4, 5, 6, 7, 8, 9, 10, 11, 12, 13, 14, 15); } \
        asm volatile("" : "+v"(ql_), "+v"(qh_), "+v"(k0l_), "+v"(k0h_), "+v"(k1l_), "+v"(k1h_));     \
        const i32x8q q8_ = __builtin_shufflevector(ql_, qh_, 0, 1, 2, 3, 4, 5, 6, 7), k08_ = __builtin_shufflevector(k0l_, k0h_, 0, 1, 2, 3, 4, 5, 6, 7), k18_ = __builtin_shufflevector(k1l_, k1h_, 0, 1, 2, 3, 4, 5, 6, 7); \
        SA_ = __builtin_amdgcn_mfma_scale_f32_32x32x64_f8f6f4(k08_, q8_, cin_, 0, 0, 0, 0x7f7f7f7f, 0, 0x7c7c7c7c);     \
        SB_ = __builtin_amdgcn_mfma_scale_f32_32x32x64_f8f6f4(k18_, q8_, cin_, 0, 0, 0, 0x7f7f7f7f, 0, 0x7c7c7c7c); } while (0)
    ATT_VMW(); ATT_BAR();
    if (grp == 1) ATT_BAR();
    int kcur = 0, knxt = KBUF, kfree = 2 * KBUF;
#define DF_VLD() do { _Pragma("unroll") for (int mb = 0; mb < 2; ++mb) { vl_[mb] = *(const ATT_LAS i32x4q*)(Vimg + mb * 2048 + kfe); vh_[mb] = *(const ATT_LAS i32x4q*)(Vimg + mb * 2048 + vfo_); } } while (0)
#define DF_SEG(SUB, M_, L_, O_) do { \
        const ATT_LAS unsigned char* Vimg = lds + L_V + (t & 3) * 8192; int vfo_ = kfe; asm volatile("v_xor_b32 %0, 16, %0" : "+v"(vfo_)); \
        i32x4q vl_[4], vh_[4]; \
        DF_QKX(kcur, SUB, false, sa, sb);     \
        DF_VLD();     \
        if (t == 0 || !softmax_fast8(sa, sb, L_, pq1)) { if (t != 0) DF_QKX(kcur, SUB, true, sa, sb); softmax_step8(sa, sb, M_, L_, O_, pq1, (ATT_LAS f32x4*)(qst + 4096 + (SUB) * 1024 + lane * 16)); DF_VLD();     } \
        _Pragma("unroll") for (int mb = 2; mb < 4; ++mb) { vl_[mb] = *(const ATT_LAS i32x4q*)(Vimg + mb * 2048 + kfe); vh_[mb] = *(const ATT_LAS i32x4q*)(Vimg + mb * 2048 + vfo_); } \
        asm volatile("" : "+v"(vl_[0]), "+v"(vh_[0]), "+v"(vl_[1]), "+v"(vh_[1])); \
        _Pragma("unroll") for (int mb = 0; mb < 2; ++mb) { const i32x8q vf_ = __builtin_shufflevector(vl_[mb], vh_[mb], 0, 1, 2, 3, 4, 5, 6, 7); \
            O_[mb] = __builtin_amdgcn_mfma_scale_f32_32x32x64_f8f6f4(vf_, pq1, O_[mb], 0, 0, 0, 0x7f7f7f7f, 0, 0x7f7f7f7f); } \
        asm volatile("" : "+v"(vl_[2]), "+v"(vh_[2]), "+v"(vl_[3]), "+v"(vh_[3])); \
        _Pragma("unroll") for (int mb = 2; mb < 4; ++mb) { const i32x8q vf_ = __builtin_shufflevector(vl_[mb], vh_[mb], 0, 1, 2, 3, 4, 5, 6, 7); \
            O_[mb] = __builtin_amdgcn_mfma_scale_f32_32x32x64_f8f6f4(vf_, pq1, O_[mb], 0, 0, 0, 0x7f7f7f7f, 0, 0x7f7f7f7f); } } while (0)
#pragma unroll 1
    for (int t = 0; t < NT; ++t) {
        if (X_DMA && grp == 1) { if (t + 2 < NT) { DF_DMA_K(t + 2, kfree); DF_DMA_V(t + 2); } }
        DF_SEG(0, m1, l1, o1);
        __builtin_amdgcn_sched_barrier(0);
        if (X_DMA && grp == 0) ATT_VMW();
        ATT_BAR();
        if (X_DMA && grp == 0) { if (t + 2 < NT) { DF_DMA_K(t + 2, kfree); DF_DMA_V(t + 2); } }
        DF_SEG(1, m2, l2, o2);
        __builtin_amdgcn_sched_barrier(0);
        if (X_DMA && grp == 1) ATT_VMW();
        ATT_BAR();
        { const int k_ = kcur; kcur = knxt; knxt = kfree; kfree = k_; }
    }
#undef DF_SEG
#undef DF_VLD
    if (grp == 0) ATT_BAR();
#undef DF_QKX
#undef DF_DMA_K
#undef DF_OFFS
#undef DF_DMA_V
#undef DF_TROW
    l1 = half_sum(l1); l2 = half_sum(l2);
    { const float i1 = __builtin_amdgcn_rcpf(l1), i2 = wsf[120] * __builtin_amdgcn_rcpf(l2);
      float ss = 0.f;
#pragma unroll
      for (int mb = 0; mb < 4; ++mb)
#pragma unroll
          for (int r = 0; r < 16; ++r) { const float v = o1[mb][r] * i1 - o2[mb][r] * i2; o1[mb][r] = v; ss += v * v; }
      ss = half_sum(ss);
      const float rn = __builtin_amdgcn_rsqf(ss * (1.0f / 128.0f) + 1e-6f) * outscale;
      int lane_e; asm volatile("v_mbcnt_lo_u32_b32 %0, -1, 0\n\tv_mbcnt_hi_u32_b32 %0, -1, %0" : "=v"(lane_e)); const int r32e = lane_e & 31, hie = lane_e >> 5;
      bf16_t* Ow = O + (size_t)(qrow + r32e) * PITCH + hd * 128 + 4 * hie;
#pragma unroll
      for (int mb = 0; mb < 4; ++mb)
#pragma unroll
          for (int a = 0; a < 4; ++a) { const f32x4 g4 = *(const f32x4*)(subln + 32 * mb + 8 * a + 4 * hie);
              typedef unsigned u32x2q __attribute__((ext_vector_type(2)));
              u32x2q w; w.x = cvtpk(o1[mb][4 * a] * rn * g4[0], o1[mb][4 * a + 1] * rn * g4[1]); w.y = cvtpk(o1[mb][4 * a + 2] * rn * g4[2], o1[mb][4 * a + 3] * rn * g4[3]);
              *(u32x2q*)(Ow + 32 * mb + 8 * a) = w; } }
    ATT_LDSW();
}
}

#define GAS __attribute__((address_space(1)))
#define LAS __attribute__((address_space(3)))
typedef unsigned short bf16;
typedef unsigned v4u __attribute__((ext_vector_type(4)));
typedef float f32x4 __attribute__((ext_vector_type(4)));
typedef short bf16x8 __attribute__((ext_vector_type(8)));
typedef GAS unsigned gu32;
typedef GAS unsigned long long gu64;
#define RLX_AGENT __ATOMIC_RELAXED, __HIP_MEMORY_SCOPE_AGENT
#define LDS_WAIT() asm volatile("s_waitcnt lgkmcnt(0)" ::: "memory")
#define VM_WAIT() asm volatile("s_waitcnt vmcnt(0)" ::: "memory")
__device__ __forceinline__ unsigned long long rt() { return __builtin_amdgcn_s_memrealtime(); }
__device__ __forceinline__ unsigned f2bf(float f) { unsigned u = __builtin_bit_cast(unsigned, f); return (u + 0x7fffu + ((u >> 16) & 1u)) >> 16; }
__device__ __forceinline__ unsigned pk2(float lo, float hi) { return f2bf(lo) | (f2bf(hi) << 16); }

#define XB_TMO      128
#define XB_XCNT(j)  (256  + 64 * (j))
#define XB_XSUB(j)  (1280 + 64 * (j))
#define XB_XGEN(j)  (2304 + 64 * (j))
#define XB_TOP      3328
#define XB_TOPGEN   3392
#define XCD_BAR_WORDS 3456
#define XB_SPIN_CAP (1u << 18)

__device__ __forceinline__ unsigned xb_ld(unsigned* p)              { return __hip_atomic_load(p, __ATOMIC_RELAXED, __HIP_MEMORY_SCOPE_AGENT); }
__device__ __forceinline__ unsigned xb_add(unsigned* p, unsigned v) { return __hip_atomic_fetch_add(p, v, __ATOMIC_RELAXED, __HIP_MEMORY_SCOPE_AGENT); }
__device__ __forceinline__ unsigned xb_xcc_id() { return (unsigned)__builtin_amdgcn_s_getreg((3 << 11) | 20) & 0xFu; }
#define XB_SPIN(cond, bar) do { unsigned _sp = 0; while (cond) { __builtin_amdgcn_s_sleep(1); \
    if ((++_sp & 255u) == 0u) { if (xb_ld(&(bar)[XB_TMO])) break; if (_sp > XB_SPIN_CAP) { atomicAdd(&(bar)[XB_TMO], 1u); break; } } } } while (0)

struct XcdBarrier {
    unsigned* bar; unsigned x;
    volatile LAS unsigned* st;
};

__device__ __forceinline__ XcdBarrier xcd_barrier_post(unsigned* bar, volatile LAS unsigned* st) {
    XcdBarrier b; b.bar = bar; b.x = xb_xcc_id(); b.st = st;
    if (threadIdx.x == 0) (void)xb_add(&bar[XB_XCNT(b.x)], 1u);
    return b;
}
__device__ __forceinline__ void xcd_barrier_complete(unsigned* bar, unsigned x, unsigned& nloc, unsigned& nx) {
    const unsigned G = gridDim.x * gridDim.y * gridDim.z;
    unsigned sum, cnt, mine, sp = 0u;
    for (;;) {
        sum = 0u; cnt = 0u; mine = 0u;
#pragma unroll
        for (unsigned j = 0; j < 16; ++j) { const unsigned c = xb_ld(&bar[XB_XCNT(j)]); sum += c; cnt += (c > 0u) ? 1u : 0u; mine = (j == x) ? c : mine; }
        if (sum == G) break;
        __builtin_amdgcn_s_sleep(1);
        if ((++sp & 255u) == 0u) { if (xb_ld(&bar[XB_TMO])) break; if (sp > XB_SPIN_CAP) { atomicAdd(&bar[XB_TMO], 1u); break; } }
    }
    nloc = mine > 0u ? mine : 1u; nx = cnt > 0u ? cnt : 1u;
}

__device__ __forceinline__ void xcd_barrier(const XcdBarrier& b) {
    asm volatile("s_waitcnt vmcnt(0)" ::: "memory");
    __syncthreads();
    if (threadIdx.x == 0) {
        unsigned* bar = b.bar;
        __builtin_amdgcn_s_waitcnt(0);
        unsigned nloc = b.st[0], nx = b.st[1];
        if (nloc == 0u) { xcd_barrier_complete(bar, b.x, nloc, nx); b.st[0] = nloc; b.st[1] = nx; }
        const unsigned old = xb_add(&bar[XB_XSUB(b.x)], 1u);
        const unsigned gen = old / nloc;
        if (old + 1u == (gen + 1u) * nloc) {
            __builtin_amdgcn_fence(__ATOMIC_RELEASE, "agent");
            asm volatile("s_waitcnt vmcnt(0)" ::: "memory");
            const unsigned og = xb_add(&bar[XB_TOP], 1u);
            const unsigned tg = og / nx;
            if (og + 1u == (tg + 1u) * nx) xb_add(&bar[XB_TOPGEN], 1u);
            else XB_SPIN(xb_ld(&bar[XB_TOPGEN]) == tg, bar);
            __builtin_amdgcn_fence(__ATOMIC_ACQUIRE, "agent");
            xb_add(&bar[XB_XGEN(b.x)], 1u);
            asm volatile("s_waitcnt vmcnt(0)" ::: "memory");
        } else {
            XB_SPIN(xb_ld(&bar[XB_XGEN(b.x)]) == gen, bar);
            __builtin_amdgcn_fence(__ATOMIC_ACQUIRE, "agent");
            asm volatile("s_waitcnt vmcnt(0)" ::: "memory");
        }
    }
    __syncthreads();
}
namespace cfg {
constexpr int D = 1024, NB = 16, SEQ = 2048, CTXL = 256;
constexpr int ML = NB * SEQ, MC = NB * CTXL, MT = ML + MC;
constexpr int DFF = 2816, NE = 8, DFE = 3584, MODW = 6 * D;
constexpr int MOE_TILES_MAX = 264;
constexpr float EPS = 1e-6f, LOG2E = 1.4426950408889634f;
constexpr float LAM_INIT = 0.35550906759096925f;
}
using namespace cfg;
constexpr int NWAVES = 8;
#ifndef PROBE_PHASE
#define PROBE_PHASE -1
#endif
#ifndef PROBE_N
#define PROBE_N 2
#endif
#define REPS(k) ((PROBE_PHASE == (k)) ? PROBE_N : 1)
constexpr size_t MiB = 1u << 20;
constexpr size_t WS_CTL = 0, CTL_ZERO_BYTES = 1 * MiB;
constexpr size_t WS_MOD = 1 * MiB;
constexpr size_t WS_ROPE = 2 * MiB;
constexpr size_t WS_TOKE = 3 * MiB, WS_TOKW = WS_TOKE + 256 * 1024, WS_TOKP = WS_TOKW + 256 * 1024, WS_TOKS = WS_TOKP + 256 * 1024;
constexpr size_t WS_SSQ = 4 * MiB, WS_C6 = 6 * MiB + 512 * 1024, WS_C9 = 7 * MiB;
constexpr size_t WS_W0QKV = 8 * MiB, WS_W0O = 14 * MiB, WS_W0GU = 16 * MiB, WS_W0D = 27 * MiB, WS_W1QKV = 33 * MiB, WS_W1O = 39 * MiB;
constexpr size_t WS_WMGU = 42 * MiB, WS_WMD = 98 * MiB;
constexpr float WSCALE = 64.0f;
constexpr size_t WS_R = 128 * MiB;
constexpr size_t WS_H = WS_R, WS_Q = WS_R + 72 * MiB, WS_K = WS_R + 144 * MiB, WS_V = WS_R + 216 * MiB, WS_XCTX = WS_R + 288 * MiB;
constexpr size_t WS_ACT0 = WS_Q;
constexpr size_t WS_Y = WS_R, WS_APERM = WS_R, WS_H2 = WS_R + 132 * MiB, WS_ACT1 = WS_R + 164 * MiB, WS_END = WS_ACT1 + 231 * MiB;
constexpr size_t WS_PART = WS_END, WS_END2 = WS_PART + (size_t)36 * 7 * 256 * 256 * 4;
static_assert(WS_END2 <= 593 * MiB, "d_ws map");
static_assert(WS_WMD + (size_t)NE * D * DFE <= WS_R && WS_ACT0 + (size_t)MT * DFF * 2 <= WS_XCTX && WS_XCTX + (size_t)MC * D * 4 <= WS_END && WS_H2 >= WS_Y + (size_t)MOE_TILES_MAX * 256 * D * 2 && WS_ACT1 >= WS_H2 + (size_t)ML * D && WS_END <= 593 * MiB, "d_ws map");
constexpr int CW_CNT = 1024;
constexpr int CW_BAR = 4096;
constexpr int RING_OFF = 0, RING_BYTES = 155648;
constexpr int LDSCTL_OFF = RING_BYTES, MISC_OFF = LDSCTL_OFF + 320;
constexpr int TILE_E_OFF = MISC_OFF + 128;
constexpr int EBASE_OFF = TILE_E_OFF + 272 * 4;
constexpr int LDS_BYTES = 157696;
static_assert(EBASE_OFF + 128 <= LDS_BYTES, "LDS map");

__device__ __forceinline__ float wave_sum(float v) {
    v += xl::swz_xor<1>(v); v += xl::swz_xor<2>(v); v += xl::swz_xor<4>(v); v += xl::swz_xor<8>(v); v += xl::swz_xor<16>(v);
    return xl::half_sum(v);
}
__device__ __forceinline__ void transpose_item(const float* W, int K, int N, bf16* WT, int k0, int n0, int drow0, LAS float* scr, int lane) {
#pragma unroll 8
    for (int i = 0; i < 32; ++i) { const int kk = 2 * i + (lane >> 5); scr[kk * 33 + (lane & 31)] = W[(size_t)(k0 + kk) * N + n0 + (lane & 31)]; }
    LDS_WAIT(); asm volatile("" ::: "memory");
    const int c = lane & 7;
#pragma unroll
    for (int j = 0; j < 4; ++j) { const int n = (lane >> 3) + 8 * j; const LAS float* s = scr + (8 * c) * 33 + n;
        v4u o; o.x = pk2(s[0 * 33], s[1 * 33]); o.y = pk2(s[2 * 33], s[3 * 33]); o.z = pk2(s[4 * 33], s[5 * 33]); o.w = pk2(s[6 * 33], s[7 * 33]);
        *(GAS v4u*)(WT + (size_t)(drow0 + n) * K + k0 + 8 * c) = o; }
    LDS_WAIT(); asm volatile("" ::: "memory");
}
__device__ __forceinline__ void transpose_item8(const float* W, int K, int N, unsigned char* WT, int k0, int n0, int drow0, float scale, LAS float* scr, int lane) {
#pragma unroll 8
    for (int i = 0; i < 32; ++i) { const int kk = 2 * i + (lane >> 5); scr[kk * 33 + (lane & 31)] = W[(size_t)(k0 + kk) * N + n0 + (lane & 31)] * scale; }
    LDS_WAIT(); asm volatile("" ::: "memory");
    const int c = lane & 7;
#pragma unroll
    for (int j = 0; j < 4; ++j) { const int n = (lane >> 3) + 8 * j; const LAS float* s = scr + (8 * c) * 33 + n;
        unsigned long long o = (unsigned long long)pg8::pk4_fp8(s[0 * 33], s[1 * 33], s[2 * 33], s[3 * 33]) | ((unsigned long long)pg8::pk4_fp8(s[4 * 33], s[5 * 33], s[6 * 33], s[7 * 33]) << 32);
        *(GAS unsigned long long*)(WT + (size_t)(drow0 + n) * K + k0 + 8 * c) = o; }
    LDS_WAIT(); asm volatile("" ::: "memory");
}
struct CvtMat { const float* src; void* dst; int K, N, mode, nmat; float fp8scale; };
__device__ __forceinline__ void cvt_run(const CvtMat& cm, int it, LAS float* scr, int lane) {
    const int nblk = cm.N / 32, per = (cm.K / 64) * nblk;
    const int e = it / per, r = it % per, kb = r / nblk, nb = r % nblk, n0 = nb * 32;
    const int drow0 = (cm.mode == 0) ? n0 : ((n0 >> 7) * 256 + (n0 & 127) + (cm.mode == 2 ? 128 : 0));
    const int rows_per = (cm.mode == 0) ? cm.N : 2 * cm.N;
    if (cm.fp8scale != 0.f) transpose_item8(cm.src + (size_t)e * cm.K * cm.N, cm.K, cm.N, (unsigned char*)cm.dst + (size_t)e * rows_per * cm.K, kb * 64, n0, drow0, cm.fp8scale, scr, lane);
    else transpose_item(cm.src + (size_t)e * cm.K * cm.N, cm.K, cm.N, (bf16*)cm.dst + (size_t)e * rows_per * cm.K, kb * 64, n0, drow0, scr, lane);
}
__device__ __forceinline__ void moe_cvt_range(int lo, int hi, int widx, int nw, const float* wg, const float* wu, const float* wd, unsigned char* gu8, unsigned char* d8, float scale, LAS float* scr, int lane) {
    constexpr int PER = (D / 64) * (DFE / 32) * NE;
    for (int I = lo + widx; I < hi; I += nw) { const int mi = I / PER, it = I - mi * PER;
        if (mi == 0) { const CvtMat cm{wg, gu8, D, DFE, 1, NE, scale}; cvt_run(cm, it, scr, lane); }
        else if (mi == 1) { const CvtMat cm{wu, gu8, D, DFE, 2, NE, scale}; cvt_run(cm, it, scr, lane); }
        else { const CvtMat cm{wd, d8, DFE, D, 0, NE, scale}; cvt_run(cm, it, scr, lane); } }
}
constexpr int MOE_ITEMS = 3 * (D / 64) * (DFE / 32) * NE;
constexpr int MC0 = 0, MC1 = 0, MC2 = MC1 + MOE_ITEMS * 25 / 100, MC3 = MC2 + MOE_ITEMS * 20 / 100, MC4 = MOE_ITEMS, MC5 = MC4;
template <bool F8 = false, bool PRE = false>
__device__ __forceinline__ void norm_mod_row(const float* xrow, const float* gain, const float* shift, const float* scale, void* orow, int lane, f32x4 (&v)[4]) {
    const GAS f32x4* xr = (const GAS f32x4*)xrow + lane; float s2 = 0.f;
#pragma unroll
    for (int j = 0; j < 4; ++j) { if constexpr (!PRE) v[j] = xr[64 * j]; s2 += (v[j].x * v[j].x + v[j].y * v[j].y) + (v[j].z * v[j].z + v[j].w * v[j].w); }
    const float rstd = 1.0f / sqrtf(wave_sum(s2) * (1.f / D) + EPS);
    GAS unsigned long long* o8 = (GAS unsigned long long*)orow + lane;
#pragma unroll
    for (int j = 0; j < 4; ++j) { const f32x4 g = ((const f32x4*)gain)[lane + 64 * j], sh = ((const f32x4*)shift)[lane + 64 * j], sc = ((const f32x4*)scale)[lane + 64 * j];
        v[j] = (v[j] * rstd * g) * (sc + 1.0f) + sh;
        if constexpr (F8) ((GAS unsigned*)orow)[lane + 64 * j] = pg8::pk4_fp8(v[j].x, v[j].y, v[j].z, v[j].w);
        else o8[64 * j] = (unsigned long long)pk2(v[j].x, v[j].y) | ((unsigned long long)pk2(v[j].z, v[j].w) << 32); }
}

template <bool F8 = false>
__device__ __forceinline__ void norm_mod_row2(const float* xa, const float* xb, const float* gain, const float* sha, const float* sca, const float* shb, const float* scb, void* oa, void* ob, int lane) {
    const GAS f32x4* pa = (const GAS f32x4*)xa + lane; const GAS f32x4* pb = (const GAS f32x4*)xb + lane; f32x4 va[4], vb[4]; float sa = 0.f, sb = 0.f;
#pragma unroll
    for (int j = 0; j < 4; ++j) { va[j] = pa[64 * j]; vb[j] = pb[64 * j]; }
#pragma unroll
    for (int j = 0; j < 4; ++j) { sa += (va[j].x * va[j].x + va[j].y * va[j].y) + (va[j].z * va[j].z + va[j].w * va[j].w); sb += (vb[j].x * vb[j].x + vb[j].y * vb[j].y) + (vb[j].z * vb[j].z + vb[j].w * vb[j].w); }
    sa += xl::swz_xor<1>(sa); sb += xl::swz_xor<1>(sb); sa += xl::swz_xor<2>(sa); sb += xl::swz_xor<2>(sb); sa += xl::swz_xor<4>(sa); sb += xl::swz_xor<4>(sb);
    sa += xl::swz_xor<8>(sa); sb += xl::swz_xor<8>(sb); sa += xl::swz_xor<16>(sa); sb += xl::swz_xor<16>(sb); sa = xl::half_sum(sa); sb = xl::half_sum(sb);
    const float ra = 1.0f / sqrtf(sa * (1.f / D) + EPS), rb = 1.0f / sqrtf(sb * (1.f / D) + EPS);
    GAS unsigned long long* qa = (GAS unsigned long long*)oa + lane; GAS unsigned long long* qb = (GAS unsigned long long*)ob + lane;
#pragma unroll
    for (int j = 0; j < 4; ++j) { const f32x4 g = ((const f32x4*)gain)[lane + 64 * j];
        const f32x4 ha = (va[j] * ra * g) * (((const f32x4*)sca)[lane + 64 * j] + 1.0f) + ((const f32x4*)sha)[lane + 64 * j];
        const f32x4 hb = (vb[j] * rb * g) * (((const f32x4*)scb)[lane + 64 * j] + 1.0f) + ((const f32x4*)shb)[lane + 64 * j];
        if constexpr (F8) { ((GAS unsigned*)oa)[lane + 64 * j] = pg8::pk4_fp8(ha.x, ha.y, ha.z, ha.w); ((GAS unsigned*)ob)[lane + 64 * j] = pg8::pk4_fp8(hb.x, hb.y, hb.z, hb.w); }
        else { qa[64 * j] = (unsigned long long)pk2(ha.x, ha.y) | ((unsigned long long)pk2(ha.z, ha.w) << 32);
        qb[64 * j] = (unsigned long long)pk2(hb.x, hb.y) | ((unsigned long long)pk2(hb.z, hb.w) << 32); } }
}

__device__ __forceinline__ void shift_dot_rows(const bf16* Wt, int N, float* c, const LAS float* shL, int gw, int ngw, int lane) {
    for (int n = gw; n < N; n += ngw) { const GAS unsigned long long* wp = (const GAS unsigned long long*)(Wt + (size_t)n * D) + lane; f32x4 w[4];
#pragma unroll
        for (int j = 0; j < 4; ++j) { const unsigned long long a = wp[64 * j]; w[j].x = __uint_as_float((unsigned)a << 16); w[j].y = __uint_as_float((unsigned)a & 0xffff0000u); w[j].z = __uint_as_float((unsigned)(a >> 32) << 16); w[j].w = __uint_as_float((unsigned)(a >> 32) & 0xffff0000u); }
#pragma unroll 1
        for (int b = 0; b < 17; ++b) { float s = 0.f;
#pragma unroll
            for (int j = 0; j < 4; ++j) { const f32x4 h = *(const LAS f32x4*)(shL + b * 1024 + 4 * lane + 256 * j); s += (h.x * w[j].x + h.y * w[j].y) + (h.z * w[j].z + h.w * w[j].w); }
            s = wave_sum(s); if (lane == 0) c[(size_t)b * N + n] = s; } }
}

typedef float f32x16_t __attribute__((ext_vector_type(16)));
constexpr int SD_PITCH = 2064, SD_PART = 32 * SD_PITCH;
__device__ __forceinline__ void shift_img(const float* shift_rows  , LAS unsigned char* lds, int tid) {
    __syncthreads();
    const int k = tid * 2;
    typedef float f32x2_t __attribute__((ext_vector_type(2)));
    f32x2_t v[17];
#pragma unroll
    for (int r = 0; r < 17; ++r) v[r] = *(const f32x2_t*)(shift_rows + (size_t)r * MODW + k);
#pragma unroll
    for (int r = 0; r < 32; ++r) *(LAS unsigned*)(lds + r * SD_PITCH + k * 2) = (r < 17) ? pk2(v[r < 17 ? r : 0].x, v[r < 17 ? r : 0].y) : 0u;
    __syncthreads();
}
__device__ __forceinline__ void shift_dots(const float* mod, const bf16* W6, float* c6, const bf16* W9, float* c9, int idx, int nidle, LAS unsigned char* lds, int wave, int tid) {
    constexpr int NB6 = 2 * DFF / 32, NB9 = 3 * D / 32, N6 = 2 * DFF, N9 = 3 * D;
    if (idx < 0 || idx >= NB6 + NB9) return;
    int lane_l; asm volatile("v_mbcnt_lo_u32_b32 %0, -1, 0\n\tv_mbcnt_hi_u32_b32 %0, -1, %0" : "=v"(lane_l)); const int r32 = lane_l & 31, hi = lane_l >> 5;
    bf16x8 bfr[8];
#define SD_LOADB(blk_) do { const bf16* w_ = ((blk_) < NB6) ? W6 + (size_t)((blk_) * 32 + r32) * D : W9 + (size_t)(((blk_) - NB6) * 32 + r32) * D; \
        _Pragma("unroll") for (int q = 0; q < 8; ++q) bfr[q] = *(const bf16x8*)(w_ + wave * 128 + q * 16 + hi * 8); } while (0)
    SD_LOADB(idx);
    int img = 0;
    for (int blk = idx; blk < NB6 + NB9; blk += nidle) { const int want = (blk < NB6) ? 1 : 2;
        if (img != want) { shift_img(want == 1 ? mod + 3 * D : mod + (size_t)17 * MODW, lds, tid); img = want; }
        f32x16_t acc;
#pragma unroll
        for (int i = 0; i < 16; ++i) acc[i] = 0.f;
#pragma unroll
        for (int q = 0; q < 8; ++q) { const bf16x8 a = *(const LAS bf16x8*)(lds + r32 * SD_PITCH + (wave * 128 + q * 16 + hi * 8) * 2);
            acc = __builtin_amdgcn_mfma_f32_32x32x16_bf16(a, bfr[q], acc, 0, 0, 0); }
        if (blk + nidle < NB6 + NB9) SD_LOADB(blk + nidle);
        LAS float* part = (LAS float*)(lds + SD_PART) + wave * (17 * 32);
#pragma unroll
        for (int r = 0; r < 9; ++r) { const int b = (r & 3) + 8 * (r >> 2) + 4 * hi; if (b < 17) part[b * 32 + r32] = acc[r]; }
        __syncthreads();
        float* c = (blk < NB6) ? c6 : c9; const int N = (blk < NB6) ? N6 : N9, n0 = ((blk < NB6) ? blk : blk - NB6) * 32;
        for (int i = tid; i < 17 * 32; i += NWAVES * 64) { float sum = 0.f;
#pragma unroll
            for (int w = 0; w < NWAVES; ++w) sum += ((LAS float*)(lds + SD_PART))[w * (17 * 32) + i];
            c[(size_t)(i >> 5) * N + n0 + (i & 31)] = sum; }
        __syncthreads();
    }
#undef SD_LOADB
}
struct Args { const float* in[30]; float* out; unsigned char* ws; };
__global__ void __launch_bounds__(NWAVES * 64, 2) mega_fwd(Args args) {
    extern __shared__ __attribute__((aligned(16))) unsigned char lds_raw[];
    LAS unsigned char* lds = (LAS unsigned char*)lds_raw;
    volatile LAS unsigned* MISC = (volatile LAS unsigned*)(lds + MISC_OFF);
    LAS int* tile_e = (LAS int*)(lds + TILE_E_OFF);
    LAS int* ebase = (LAS int*)(lds + EBASE_OFF);
    const int G = gridDim.x, bx = blockIdx.x, vcu = (G % 8 == 0) ? (bx % 8) * (G / 8) + bx / 8 : bx;
    const int NGW = G * NWAVES;
    const int wave = __builtin_amdgcn_readfirstlane(threadIdx.x >> 6);
#define PHASE_IDS() int lane_l; asm volatile("v_mbcnt_lo_u32_b32 %0, -1, 0\n\tv_mbcnt_hi_u32_b32 %0, -1, %0" : "=v"(lane_l)); const int lane = lane_l, tid = wave * 64 + lane, gw = vcu * NWAVES + wave; (void)gw
#define x_in (args.in[0])
#define c_in (args.in[1])
#define ctx_in (args.in[2])
#define cctx_in (args.in[3])
#define l0_wada (args.in[4])
#define l0_bada (args.in[5])
#define l0_nmix (args.in[6])
#define l0_wqkv (args.in[7])
#define l0_rpb (args.in[8])
#define l0_wo (args.in[9])
#define l0_nffn (args.in[10])
#define l0_wg (args.in[11])
#define l0_wu (args.in[12])
#define l0_wd (args.in[13])
#define l1_wada (args.in[14])
#define l1_bada (args.in[15])
#define l1_nmix (args.in[16])
#define l1_wqkv (args.in[17])
#define l1_lq1 (args.in[18])
#define l1_lk1 (args.in[19])
#define l1_lq2 (args.in[20])
#define l1_lk2 (args.in[21])
#define l1_subln (args.in[22])
#define l1_wo (args.in[23])
#define l1_nffn (args.in[24])
#define l1_wr (args.in[25])
#define l1_wg (args.in[26])
#define l1_wu (args.in[27])
#define l1_wd (args.in[28])
#define fnorm (args.in[29])
#define xlat (args.out)
#define xctx ((float*)(args.ws + WS_XCTX))
#define mod ((float*)(args.ws + WS_MOD))
#define rope ((float*)(args.ws + WS_ROPE))
#define tok_e ((int*)(args.ws + WS_TOKE))
#define tok_w ((float*)(args.ws + WS_TOKW))
#define tok_p ((int*)(args.ws + WS_TOKP))
#define tok_s ((int*)(args.ws + WS_TOKS))
#define W0qkv8 ((unsigned char*)(args.ws + WS_W0QKV))
#define W1qkv8 ((unsigned char*)(args.ws + WS_W0QKV + 3 * MiB))
#define W0o ((bf16*)(args.ws + WS_W0O))
#define W0gu ((bf16*)(args.ws + WS_W0GU))
#define W0d ((bf16*)(args.ws + WS_W0D))
#define W1qkv ((bf16*)(args.ws + WS_W1QKV))
#define W1o ((bf16*)(args.ws + WS_W1O))
#define WMgu ((unsigned char*)(args.ws + WS_WMGU))
#define WMd ((unsigned char*)(args.ws + WS_WMD))
#define Hb ((bf16*)(args.ws + WS_H))
#define Qb ((bf16*)(args.ws + WS_Q))
#define Kb ((bf16*)(args.ws + WS_K))
#define Vb ((bf16*)(args.ws + WS_V))
#define ACT0 ((bf16*)(args.ws + WS_ACT0))
#define APERM ((unsigned char*)(args.ws + WS_APERM))
#define YB ((bf16*)(args.ws + WS_Y))
#define H2 ((unsigned char*)(args.ws + WS_H2))
#define ACT1 ((unsigned char*)(args.ws + WS_ACT1))
#define ctl ((gu32*)(args.ws + WS_CTL))
#define SSQ ((float*)(args.ws + WS_SSQ))
#define C6 ((float*)(args.ws + WS_C6))
#define C9 ((float*)(args.ws + WS_C9))
    for (int u = threadIdx.x; u < (LDS_BYTES - LDSCTL_OFF) / 4; u += NWAVES * 64) ((LAS unsigned*)(lds + LDSCTL_OFF))[u] = 0u;
    __syncthreads();
    XcdBarrier bar = xcd_barrier_post((unsigned*)(ctl + CW_BAR), MISC + 8);
#define GRID_BAR() xcd_barrier(bar)
#define IDLE_CVT(NUNITS, LO, HI) do { const int rem_ = (NUNITS) % G;     \
        if (rem_ != 0 && bx >= rem_) moe_cvt_range((LO), (HI), (bx - rem_) * NWAVES + wave, (G - rem_) * NWAVES, l1_wg, l1_wu, l1_wd, WMgu, WMd, WSCALE, (LAS float*)(lds + RING_OFF + wave * 16384), lane); \
        else if (rem_ == 0) moe_cvt_range((LO), (HI), gw, NGW, l1_wg, l1_wu, l1_wd, WMgu, WMd, WSCALE, (LAS float*)(lds + RING_OFF + wave * 16384), lane); } while (0)
#define ODST_REAL Kb

    {
        PHASE_IDS();
        if (bx < 192) {
            typedef float f32x16_t __attribute__((ext_vector_type(16)));
            LAS float* sl = (LAS float*)(lds + RING_OFF); LAS float* red = (LAS float*)(lds + RING_OFF + 17 * 1025 * 4 + 60);
            for (int i = tid; i < 17 * 1024; i += NWAVES * 64) { const int r = i >> 10, k = i & 1023; const float cv = (r < 16) ? c_in[r * 1024 + k] : cctx_in[k]; sl[r * 1025 + k] = cv / (1.0f + __expf(-cv)); }
            __syncthreads();
            const int layer = bx / 96, n0 = (bx % 96) * 64, col = tid & 63, ks = tid >> 6, li = lane & 31, kh = lane >> 5;
            const float* W = (layer ? l1_wada : l0_wada) + n0 + li; const float* bias = (layer ? l1_bada : l0_bada);
            const LAS float* ap = sl + ((li < 17) ? li : 0) * 1025 + ks * 128 + kh;
            f32x16_t acc0, acc1;
#pragma unroll
            for (int r = 0; r < 16; ++r) { acc0[r] = 0.f; acc1[r] = 0.f; }
            for (int kk = 0; kk < 64; kk += 8) { float w0[8], w1[8], a[8];
#pragma unroll
                for (int i = 0; i < 8; ++i) { const float* wp = W + (size_t)(ks * 128 + 2 * (kk + i) + kh) * MODW; w0[i] = wp[0]; w1[i] = wp[32]; a[i] = (li < 17) ? ap[2 * (kk + i)] : 0.f; }
#pragma unroll
                for (int i = 0; i < 8; ++i) { acc0 = __builtin_amdgcn_mfma_f32_32x32x2f32(a[i], w0[i], acc0, 0, 0, 0); acc1 = __builtin_amdgcn_mfma_f32_32x32x2f32(a[i], w1[i], acc1, 0, 0, 0); } }
#pragma unroll
            for (int r = 0; r < 9; ++r) { const int row = (r & 3) + 8 * (r >> 2) + 4 * kh; if (row < 17) { red[(ks * 17 + row) * 64 + li] = acc0[r]; red[(ks * 17 + row) * 64 + 32 + li] = acc1[r]; } }
            __syncthreads();
            for (int i = tid; i < 17 * 64; i += NWAVES * 64) { const int r = i >> 6, cc = i & 63; float s = bias[n0 + cc];
#pragma unroll
                for (int q = 0; q < 8; ++q) s += red[(q * 17 + r) * 64 + cc];
                mod[(size_t)(layer * 17 + r) * MODW + n0 + cc] = s; }
            __syncthreads(); (void)col;
        }
        if (bx == 192 || (G <= 192 && bx == 0)) {
            for (int i = tid; i < 64 * 16; i += NWAVES * 64) { const int pos = i >> 4, f = i & 15; double inv = 1.0; for (int q = 0; q < f; ++q) inv *= 0.5623413251903491;
                const double a = (double)pos * inv; const double kq = __builtin_rint(a * 0.6366197723675814); const double rr = (a - kq * 1.5707963267948966) - kq * 6.123233995736766e-17; const double r2 = rr * rr;
                double sn = rr * (1.0 + r2 * (-1.0 / 6 + r2 * (1.0 / 120 + r2 * (-1.0 / 5040 + r2 * (1.0 / 362880 + r2 * (-1.0 / 39916800 + r2 * (1.0 / 6227020800.0)))))));
                double cn = 1.0 + r2 * (-0.5 + r2 * (1.0 / 24 + r2 * (-1.0 / 720 + r2 * (1.0 / 40320 + r2 * (-1.0 / 3628800 + r2 * (1.0 / 479001600.0 + r2 * (-1.0 / 87178291200.0)))))));
                const int qd = ((int)kq) & 3; double cs = cn, ss = sn; if (qd == 1) { cs = -sn; ss = cn; } else if (qd == 2) { cs = -cn; ss = -sn; } else if (qd == 3) { cs = sn; ss = -cn; }
                rope[2 * i] = (float)cs; rope[2 * i + 1] = (float)ss; }
        }
        LAS float* scr = (LAS float*)(lds + RING_OFF + wave * 16384);
        int itbase = 0;
#undef CVT
#define CVT(SRC, DST, KK, NN, MODE, NMAT, F8) do { const CvtMat cm_{SRC, DST, KK, NN, MODE, NMAT, F8}; const int nit_ = ((KK) / 64) * ((NN) / 32) * (NMAT); \
            int first_ = (gw - itbase) % NGW; if (first_ < 0) first_ += NGW; for (int it = first_; it < nit_; it += NGW) cvt_run(cm_, it, scr, lane); itbase += nit_; } while (0)
        CVT(l0_wqkv, W0qkv8, D, 3 * D, 0, 1, WSCALE); CVT(l1_wqkv, W1qkv8, D, 3 * D, 0, 1, WSCALE); CVT(l0_wo, W0o, D, D, 0, 1, 0.f); CVT(l0_wg, W0gu, D, DFF, 1, 1, 0.f); CVT(l0_wu, W0gu, D, DFF, 2, 1, 0.f); CVT(l0_wd, W0d, DFF, D, 0, 1, WSCALE);
        CVT(l1_wqkv, W1qkv, D, 3 * D, 0, 1, 0.f); CVT(l1_wo, W1o, D, D, 0, 1, 0.f);
        moe_cvt_range(MC5, MOE_ITEMS, ((gw - itbase) % NGW + NGW) % NGW, NGW, l1_wg, l1_wu, l1_wd, WMgu, WMd, WSCALE, scr, lane);
    }
    GRID_BAR();

    { PHASE_IDS();
    for (int m = gw; m < MT; m += 2 * NGW) { const int m2 = m + NGW; const bool lat = m < ML, has2 = m2 < MT, lat2 = has2 && m2 < ML; const int mb = has2 ? m2 : m;
        const float* mp = mod + (size_t)((lat ? (m >> 11) : 16)) * MODW; const float* mq = mod + (size_t)(((has2 ? lat2 : lat) ? (mb >> 11) : 16)) * MODW;
        norm_mod_row2<true>(lat ? x_in + (size_t)m * D : ctx_in + (size_t)(m - ML) * D, (has2 ? lat2 : lat) ? x_in + (size_t)mb * D : ctx_in + (size_t)(mb - ML) * D, l0_nmix, mp + 0, mp + D, mq + 0, mq + D, (unsigned char*)Hb + (size_t)m * D, (unsigned char*)Hb + (size_t)mb * D, lane); }
    }
    GRID_BAR();

    { PHASE_IDS(); pg8::Gemm g{Hb, (const pg8::bf16_t*)W0qkv8, MT, 3 * D, D / 2}; pg8::StaticOrder S; S.init(MT, 3 * D, G, bx);
      pg8::EpiQKV<false, false, true> E{Qb, (size_t)MT * D, nullptr, nullptr, 0, nullptr, 0, 1.0f / WSCALE, (unsigned char*)Qb, (size_t)MT * D};
      pg8::gemm_phase<pg8::EpiQKV<false, false, true>, pg8::StaticOrder, true, true, true>(lds + RING_OFF, g, S, E, tid);
      { const int nu = (MT / 256) * (3 * D / 256), rem = nu % G, nidle = rem ? G - rem : G, idx = rem ? bx - rem : bx;
        shift_dots(mod, W0gu, C6, W1qkv, C9, idx, nidle, lds + RING_OFF, wave, tid); } }
    GRID_BAR();

    { PHASE_IDS(); bf16* Odst = ODST_REAL;
    { const bool grp8 = (G & 7) == 0; const int ng = G >> 3, nctx = (NB * 16 + G - 1) / G, nlat = grp8 ? (NB * 16 + ng - 1) / ng : 0, total = grp8 ? nlat + nctx : 9 * nctx;
      for (int j = 0; j < total; ++j) { int bh, rg;
          if (grp8) { if (j < nlat) { bh = (vcu >> 3) + j * ng; rg = vcu & 7; } else { bh = vcu + (j - nlat) * G; rg = 8; } } else { bh = vcu + (j / 9) * G; rg = j % 9; }
          if (bh < NB * 16) att::na_unit(bh >> 4, bh & 15, rg, (const unsigned char*)Qb, (const unsigned char*)Qb + (size_t)MT * D, Vb, Odst, l0_rpb, lds + RING_OFF, wave); } } }
    GRID_BAR();

    { PHASE_IDS(); pg8::Gemm g{Kb, W0o, MT, D, D}; pg8::StaticOrder S; S.init(MT, D, G, bx);
      pg8::EpiResidN E{x_in, ctx_in, xlat, xctx, mod + 2 * D, Hb, l0_nffn, mod + 4 * D, SSQ, 1.0f, MT};
      pg8::gemm_phase<pg8::EpiResidN, pg8::StaticOrder, true, true>(lds + RING_OFF, g, S, E, tid);
      IDLE_CVT((MT / 256) * (D / 256), MC1, MC2); }
    GRID_BAR();


    { PHASE_IDS(); pg8::Gemm g{Hb, W0gu, MT, 2 * DFF, D}; pg8::StaticOrder S; S.init(MT, 2 * DFF, G, bx);
      pg8::EpiSwiGLU8N E{(unsigned char*)ACT0, DFF, SSQ, MT, C6, 2 * DFF};
      pg8::gemm_phase<pg8::EpiSwiGLU8N, pg8::StaticOrder, true, true>(lds + RING_OFF, g, S, E, tid);
      IDLE_CVT((MT / 256) * (2 * DFF / 256), MC2, MC3); }
    GRID_BAR();

    { PHASE_IDS(); pg8::Gemm g{ACT0, W0d, MT, D, DFF / 2}; pg8::StaticOrder S; S.init(MT, D, G, bx);
      pg8::EpiResidNT<true> E{xlat, xctx, xlat, xctx, mod + 5 * D, Hb, l1_nmix, mod + (size_t)17 * MODW + D, SSQ, 1.0f / WSCALE, MT};
      pg8::gemm_phase<pg8::EpiResidNT<true>, pg8::StaticOrder, true, true, true>(lds + RING_OFF, g, S, E, tid);
      IDLE_CVT((MT / 256) * (D / 256), MC3, MC4); }
    GRID_BAR();


    { PHASE_IDS(); pg8::Gemm g{Hb, (const pg8::bf16_t*)W1qkv8, MT, 3 * D, D / 2}; pg8::StaticOrder S; S.init(MT, 3 * D, G, bx);
      pg8::EpiQKV<true, true, true, true> E{Qb, (size_t)MT * D, rope, SSQ, MT, C9, 3 * D, 1.0f / WSCALE, (unsigned char*)Qb, (size_t)MT * D, (unsigned char*)Vb, lds + RING_OFF + pg8::STAGE_BYTES};
      pg8::gemm_phase<pg8::EpiQKV<true, true, true, true>, pg8::StaticOrder, true, true, true>(lds + RING_OFF, g, S, E, tid); }
    GRID_BAR();

    {
        PHASE_IDS(); bf16* Odst = Kb;
        float d1 = 0.f, d2 = 0.f; d1 = l1_lq1[lane] * l1_lk1[lane]; d2 = l1_lq2[lane] * l1_lk2[lane];
        int lam_i = __builtin_amdgcn_readfirstlane(__builtin_bit_cast(int, __expf(wave_sum(d1)) - __expf(wave_sum(d2)) + LAM_INIT)); const float lam = __builtin_bit_cast(float, lam_i);
        ((LAS float*)(lds + RING_OFF + att::L_WSF))[wave * 128 + 120] = lam;
        { const bool grp8 = (G & 7) == 0; const int ng = G >> 3, nbh = NB * 8, total = grp8 ? (nbh + ng - 1) / ng : (nbh * 8 + G - 1) / G;
          for (int j = 0; j < total; ++j) { int bh, qb; if (grp8) { bh = (vcu >> 3) + j * ng; qb = vcu & 7; } else { const int u = vcu * total + j; bh = u >> 3; qb = u & 7; }
              if (bh < nbh) att::diff_unit(bh >> 3, bh & 7, qb, (const unsigned char*)Qb, (const unsigned char*)Qb + (size_t)MT * D, (const unsigned char*)Vb, Odst, lam, 1.0f - LAM_INIT, l1_subln, lds + RING_OFF, wave); } }
    }
    GRID_BAR();

    { PHASE_IDS(); pg8::Gemm g{Kb, W1o, ML, D, D}; pg8::StaticOrder S; S.init(ML, D, G, bx);
      pg8::EpiResid E{xlat, xctx, xlat, xctx, mod + (size_t)17 * MODW + 2 * D, 1.0f};
      pg8::gemm_phase<pg8::EpiResid, pg8::StaticOrder, true, true>(lds + RING_OFF, g, S, E, tid); }
    GRID_BAR();

    {
        PHASE_IDS();
        LAS float* wrl = (LAS float*)(lds + RING_OFF);
        LAS int* lcnt = (LAS int*)(lds + RING_OFF + 32768);
        LAS int* rec = (LAS int*)(lds + RING_OFF + 32768 + 64);
        for (int i = tid; i < 8192; i += NWAVES * 64) wrl[i] = l1_wr[i];
        if (tid < 16) lcnt[tid] = 0;
        __syncthreads();
        const int rows_per = (ML + G - 1) / G;
        const int row_lo = vcu * rows_per, row_hi = (row_lo + rows_per < ML) ? row_lo + rows_per : ML;
        f32x4 xn[4];
        if (row_lo + wave < row_hi) { const GAS f32x4* xr = (const GAS f32x4*)(xlat + (size_t)(row_lo + wave) * D) + lane;
#pragma unroll
            for (int j = 0; j < 4; ++j) xn[j] = xr[64 * j]; }
        for (int m = row_lo + wave; m < row_hi; m += NWAVES) { const int br = m >> 11; const float* mp = mod + (size_t)(17 + br) * MODW; f32x4 v[4];
#pragma unroll
            for (int j = 0; j < 4; ++j) v[j] = xn[j];
            if (m + NWAVES < row_hi) { const GAS f32x4* xr = (const GAS f32x4*)(xlat + (size_t)(m + NWAVES) * D) + lane;
#pragma unroll
                for (int j = 0; j < 4; ++j) xn[j] = xr[64 * j]; }
            norm_mod_row<true, true>(xlat + (size_t)m * D, l1_nffn, mp + 3 * D, mp + 4 * D, H2 + (size_t)m * D, lane, v);
            float lg[8];
#pragma unroll
            for (int e = 0; e < 8; ++e) lg[e] = 0.f;
#pragma unroll
            for (int j = 0; j < 4; ++j)
#pragma unroll
                for (int q = 0; q < 4; ++q) { const int k = 4 * lane + 256 * j + q; const f32x4 w0 = *(const LAS f32x4*)(wrl + k * 8), w1 = *(const LAS f32x4*)(wrl + k * 8 + 4); const float hv = v[j][q];
                    lg[0] += hv * w0[0]; lg[1] += hv * w0[1]; lg[2] += hv * w0[2]; lg[3] += hv * w0[3]; lg[4] += hv * w1[0]; lg[5] += hv * w1[1]; lg[6] += hv * w1[2]; lg[7] += hv * w1[3]; }
#pragma unroll
            for (int e = 0; e < 8; ++e) lg[e] = wave_sum(lg[e]);
            int e0 = 0; float b0 = lg[0];
#pragma unroll
            for (int e = 1; e < 8; ++e) if (lg[e] > b0) { b0 = lg[e]; e0 = e; }
            int e1 = -1; float b1 = -INFINITY;
#pragma unroll
            for (int e = 0; e < 8; ++e) if (e != e0 && lg[e] > b1) { b1 = lg[e]; e1 = e; }
            if (lane == 0) { const float w0 = 1.0f / (1.0f + __expf(b1 - b0)); const int lr = m - row_lo;
                const int p0 = __hip_atomic_fetch_add(&lcnt[e0], 1, __ATOMIC_RELAXED, __HIP_MEMORY_SCOPE_WORKGROUP), p1 = __hip_atomic_fetch_add(&lcnt[e1], 1, __ATOMIC_RELAXED, __HIP_MEMORY_SCOPE_WORKGROUP);
                rec[lr * 6 + 0] = e0; rec[lr * 6 + 1] = e1; rec[lr * 6 + 2] = p0; rec[lr * 6 + 3] = p1; ((LAS float*)rec)[lr * 6 + 4] = w0; ((LAS float*)rec)[lr * 6 + 5] = 1.0f - w0; }
        }
        __syncthreads();
        if (tid < 8) lcnt[8 + tid] = (int)__hip_atomic_fetch_add(ctl + CW_CNT + 64 * tid, (unsigned)lcnt[tid], RLX_AGENT);
        __syncthreads();
        for (int lr = tid; lr < row_hi - row_lo; lr += NWAVES * 64) { const int m = row_lo + lr; const int e0 = rec[lr * 6], e1 = rec[lr * 6 + 1];
            tok_e[2 * m] = e0; tok_e[2 * m + 1] = e1; tok_p[2 * m] = lcnt[8 + e0] + rec[lr * 6 + 2]; tok_p[2 * m + 1] = lcnt[8 + e1] + rec[lr * 6 + 3];
            tok_w[2 * m] = ((LAS float*)rec)[lr * 6 + 4]; tok_w[2 * m + 1] = ((LAS float*)rec)[lr * 6 + 5]; }
    }
    GRID_BAR();

    {
        PHASE_IDS();
        if (tid < 8) ebase[9 + tid] = (int)__hip_atomic_load(ctl + CW_CNT + 64 * tid, RLX_AGENT);
        __syncthreads();
        if (tid == 0) { int base = 0; for (int e = 0; e < 8; ++e) { ebase[e] = base; const int n = ebase[9 + e]; const int nt = (n + 255) >> 8;
                for (int t = 0; t < nt; ++t) tile_e[(base >> 8) + t] = e; base += nt << 8; } ebase[8] = base; }
        __syncthreads();
        for (int m = gw; m < ML; m += 4 * NGW) { v4u a[4]; int es[4][2], ps[4][2];
#pragma unroll
            for (int q = 0; q < 4; ++q) { const int mm = (m + q * NGW < ML) ? m + q * NGW : m; a[q] = ((const v4u*)(H2 + (size_t)mm * D))[lane];
                es[q][0] = tok_e[2 * mm]; es[q][1] = tok_e[2 * mm + 1]; ps[q][0] = tok_p[2 * mm]; ps[q][1] = tok_p[2 * mm + 1]; }
#pragma unroll
            for (int q = 0; q < 4; ++q) if (m + q * NGW < ML) { const int mm = m + q * NGW;
#pragma unroll
                for (int k = 0; k < 2; ++k) { const int slot = ebase[es[q][k]] + ps[q][k]; if (lane == 0) tok_s[2 * mm + k] = slot;
                    ((v4u*)(APERM + (size_t)slot * D))[lane] = a[q]; } } }
        for (int i = gw; i < 8 * 256; i += NGW) { const int e = i >> 8, j = i & 255, n = ebase[9 + e], pad = ebase[e + 1] - ebase[e] - n;
            if (j < pad) { const v4u z = {0u, 0u, 0u, 0u}; ((v4u*)(APERM + (size_t)(ebase[e] + n + j) * D))[lane] = z; } }
    }
    GRID_BAR();

    {
        const int T = ebase[8] >> 8;
        { PHASE_IDS(); pg8::Gemm g{(const pg8::bf16_t*)APERM, (const pg8::bf16_t*)WMgu, 0, 0, D / 2}; pg8::MoeOrder S; S.init(T, 2 * DFE / 256, G, vcu, tile_e);
          pg8::EpiSwiGLU8 E{ACT1, DFE, 0, tile_e, 2 * DFE / 256, 1.0f / WSCALE};
          pg8::gemm_phase<pg8::EpiSwiGLU8, pg8::MoeOrder, true, true, true>(lds + RING_OFF, g, S, E, tid); }
        GRID_BAR();
        { PHASE_IDS(); const int nun = T * (D / 256), Ltail0 = (nun / G) * G, ntail = nun - Ltail0; const bool split = ntail > 0 && ntail * 7 <= G && ntail <= 36;
          { pg8::Gemm g{(const pg8::bf16_t*)ACT1, (const pg8::bf16_t*)WMd, 0, 0, DFE / 2}; pg8::MoeOrder S; S.init(T, D / 256, G, vcu, tile_e); if (split) S.Lcap = Ltail0;
            pg8::EpiBf16GrpS E{YB, tile_e, D / 256, 1.0f / WSCALE};
            pg8::gemm_phase<pg8::EpiBf16GrpS, pg8::MoeOrder, true, true, true>(lds + RING_OFF, g, S, E, tid); }
          if (split && vcu < ntail * 7) { const int v = vcu / 7, q = vcu % 7; int ktn = 4; asm volatile("" : "+s"(ktn));
            pg8::Gemm g{(const pg8::bf16_t*)ACT1, (const pg8::bf16_t*)WMd, 0, 0, DFE / 2, ktn * q, ktn}; pg8::MoeOrder S; S.init(T, D / 256, 1 << 20, Ltail0 + v, tile_e);
            pg8::EpiPart E{(float*)(args.ws + WS_PART) + (size_t)(v * 7 + q) * 65536, 1.0f / WSCALE};
            pg8::gemm_phase<pg8::EpiPart, pg8::MoeOrder, true, true, true>(lds + RING_OFF, g, S, E, tid); } }
        GRID_BAR();
    }

    { PHASE_IDS();
    const int p18_T = ebase[8] >> 8, p18_nun = p18_T * (D / 256), p18_L0 = (p18_nun / G) * G, p18_nt = p18_nun - p18_L0, p18_Tf = p18_T & ~7, p18_nfl = p18_Tf * (D / 256);
    const bool p18_split = p18_nt > 0 && p18_nt * 7 <= G && p18_nt <= 36;
    const float* p18_part = (const float*)(args.ws + WS_PART);
#define P18_UL(s_, j) ((((s_) >> 8) < p18_Tf) ? ((((s_) >> 8) >> 3) * 32 + (j) * 8 + (((s_) >> 8) & 7)) : (p18_nfl + (((s_) >> 8) - p18_Tf) * 4 + (j)))
#define P18_SUM(s_, j) ({ const float* pp_ = p18_part + (size_t)(P18_UL(s_, j) - p18_L0) * 7 * 65536 + (size_t)((s_) & 255) * 256 + 4 * lane; f32x4 acc_ = *(const f32x4*)pp_; \
        _Pragma("unroll") for (int q_ = 1; q_ < 7; ++q_) acc_ = acc_ + *(const f32x4*)(pp_ + (size_t)q_ * 65536); acc_; })
#define P18_BF(a, o) do { o.x = __uint_as_float((unsigned)(a) << 16); o.y = __uint_as_float((unsigned)(a) & 0xffff0000u); o.z = __uint_as_float((unsigned)((a) >> 32) << 16); o.w = __uint_as_float((unsigned)((a) >> 32) & 0xffff0000u); } while (0)
    for (int m = gw; m < ML; m += 2 * NGW) { const int mb = (m + NGW < ML) ? m + NGW : m;
        const float* g2a = mod + (size_t)(17 + (m >> 11)) * MODW + 5 * D; const float* g2b = mod + (size_t)(17 + (mb >> 11)) * MODW + 5 * D;
        const int sa0 = tok_s[2 * m], sa1 = tok_s[2 * m + 1], sb0 = tok_s[2 * mb], sb1 = tok_s[2 * mb + 1]; const float wa0 = tok_w[2 * m], wa1 = tok_w[2 * m + 1], wb0 = tok_w[2 * mb], wb1 = tok_w[2 * mb + 1];
        GAS f32x4* xa = (GAS f32x4*)(xlat + (size_t)m * D) + lane; GAS f32x4* xb = (GAS f32x4*)(xlat + (size_t)mb * D) + lane;
        const unsigned long long* ya0 = (const unsigned long long*)(YB + (size_t)sa0 * D) + lane; const unsigned long long* ya1 = (const unsigned long long*)(YB + (size_t)sa1 * D) + lane;
        const unsigned long long* yb0 = (const unsigned long long*)(YB + (size_t)sb0 * D) + lane; const unsigned long long* yb1 = (const unsigned long long*)(YB + (size_t)sb1 * D) + lane;
        f32x4 va[4], vb[4]; unsigned long long qa0[4], qa1[4], qb0[4], qb1[4];
#pragma unroll
        for (int j = 0; j < 4; ++j) { va[j] = xa[64 * j]; vb[j] = xb[64 * j]; qa0[j] = ya0[64 * j]; qa1[j] = ya1[64 * j]; qb0[j] = yb0[64 * j]; qb1[j] = yb1[64 * j]; }
        float ssa = 0.f, ssb = 0.f;
        const bool anyt = p18_split && (P18_UL(sa0, 3) >= p18_L0 || P18_UL(sa1, 3) >= p18_L0 || P18_UL(sb0, 3) >= p18_L0 || P18_UL(sb1, 3) >= p18_L0);
#pragma unroll
        for (int j = 0; j < 4; ++j) { f32x4 p, q; const f32x4 ga = ((const f32x4*)g2a)[lane + 64 * j], gb = ((const f32x4*)g2b)[lane + 64 * j];
            P18_BF(qa0[j], p); P18_BF(qa1[j], q);
            if (anyt) { if (P18_UL(sa0, j) >= p18_L0) p = P18_SUM(sa0, j); if (P18_UL(sa1, j) >= p18_L0) q = P18_SUM(sa1, j); }
            va[j] = va[j] + ga * (p * wa0 + q * wa1); ssa += (va[j].x * va[j].x + va[j].y * va[j].y) + (va[j].z * va[j].z + va[j].w * va[j].w);
            P18_BF(qb0[j], p); P18_BF(qb1[j], q);
            if (anyt) { if (P18_UL(sb0, j) >= p18_L0) p = P18_SUM(sb0, j); if (P18_UL(sb1, j) >= p18_L0) q = P18_SUM(sb1, j); }
            vb[j] = vb[j] + gb * (p * wb0 + q * wb1); ssb += (vb[j].x * vb[j].x + vb[j].y * vb[j].y) + (vb[j].z * vb[j].z + vb[j].w * vb[j].w); }
        ssa += xl::swz_xor<1>(ssa); ssb += xl::swz_xor<1>(ssb); ssa += xl::swz_xor<2>(ssa); ssb += xl::swz_xor<2>(ssb); ssa += xl::swz_xor<4>(ssa); ssb += xl::swz_xor<4>(ssb);
        ssa += xl::swz_xor<8>(ssa); ssb += xl::swz_xor<8>(ssb); ssa += xl::swz_xor<16>(ssa); ssb += xl::swz_xor<16>(ssb); ssa = xl::half_sum(ssa); ssb = xl::half_sum(ssb);
        const float ra = 1.0f / sqrtf(ssa * (1.f / D) + EPS), rb = 1.0f / sqrtf(ssb * (1.f / D) + EPS);
#pragma unroll
        for (int j = 0; j < 4; ++j) { const f32x4 fn = ((const f32x4*)fnorm)[lane + 64 * j]; xa[64 * j] = va[j] * ra * fn; if (mb != m) xb[64 * j] = vb[j] * rb * fn; }
    }
#undef P18_BF
#undef P18_UL
#undef P18_SUM
    }
#undef GRID_BAR
}

extern "C" void kernel_launch(void* const* d_in, const int* in_sizes, int n_in, void* d_out, int out_size, void* d_ws, size_t ws_size, hipStream_t stream) {
    static int grid = 0;
    if (grid == 0) {
        if (n_in != 30 || out_size != ML * D || ws_size < WS_END2) { fprintf(stderr, "kernel_launch: built for 30 inputs, out of %d floats, >= %zu bytes of workspace; got n_in %d, out %d, ws %zu; nothing launched\n", ML * D, (size_t)WS_END2, n_in, out_size, ws_size); grid = -1; return; }
        int dev = 0, cus = 0, per_cu = 0;
        if (hipGetDevice(&dev) != hipSuccess || hipDeviceGetAttribute(&cus, hipDeviceAttributeMultiprocessorCount, dev) != hipSuccess) { grid = -1; return; }
        if (hipFuncSetAttribute((const void*)mega_fwd, hipFuncAttributeMaxDynamicSharedMemorySize, LDS_BYTES) != hipSuccess) { fprintf(stderr, "kernel_launch: hipFuncSetAttribute failed\n"); grid = -1; return; }
        if (hipOccupancyMaxActiveBlocksPerMultiprocessor(&per_cu, (const void*)mega_fwd, NWAVES * 64, LDS_BYTES) != hipSuccess || per_cu < 1)
            fprintf(stderr, "kernel_launch: note: occupancy query reports %d workgroups per CU\n", per_cu);
        (void)hipGetLastError();
        grid = cus;
    }
    if (grid < 0) return;
    if (hipMemsetAsync((char*)d_ws + WS_CTL, 0, CTL_ZERO_BYTES, stream) != hipSuccess) return;
    Args a{};
    for (int i = 0; i < 30; ++i) a.in[i] = (const float*)d_in[i];
    a.out = (float*)d_out; a.ws = (unsigned char*)d_ws;
    hipLaunchKernelGGL(mega_fwd, dim3(grid), dim3(NWAVES * 64), LDS_BYTES, stream, a);
}
```

```cpp
#include <hip/hip_runtime.h>
#include <cstdio>
#include <cstdint>
#include <cmath>
namespace xl {
template <int X> __device__ __forceinline__ float swz_xor(float v) { return __builtin_bit_cast(float, __builtin_amdgcn_ds_swizzle(__builtin_bit_cast(int, v), (X << 10) | 0x1f)); }
__device__ __forceinline__ void swap32(float& a, float& b) { asm volatile("v_nop\n\tv_nop\n\tv_permlane32_swap_b32 %0, %1" : "+v"(a), "+v"(b)); }
__device__ __forceinline__ float half_max(float v) { float a = v, b = v; swap32(a, b); return fmaxf(a, b); }
__device__ __forceinline__ float half_sum(float v) { float a = v, b = v; swap32(a, b); return a + b; }
__device__ __forceinline__ float other_half(float v) { float a = v, b = v; swap32(a, b);
    int lane_hi; asm("v_mbcnt_lo_u32_b32 %0, -1, 0\n\tv_mbcnt_hi_u32_b32 %0, -1, %0" : "=v"(lane_hi)); return (lane_hi >= 32) ? a : b; }
}
namespace pg8 {
#define PG8_LAS __attribute__((address_space(3)))
typedef unsigned short bf16_t;
typedef short bf16x8 __attribute__((ext_vector_type(8)));
typedef float f32x4 __attribute__((ext_vector_type(4)));
typedef unsigned u32x4 __attribute__((ext_vector_type(4)));
typedef int i32x4_t __attribute__((ext_vector_type(4)));
typedef int i32x8_t __attribute__((ext_vector_type(8)));
typedef unsigned u32x2 __attribute__((ext_vector_type(2)));
constexpr int BM = 256, BK = 64, HALF = 128, HTB = HALF * BK * 2  , STAGE_BYTES = 8 * HTB, NXCD = 8, WGM = 8;

__host__ __device__ __forceinline__ int lds_byte(int r, int c) { const int st = (r >> 4) * 2 + (c >> 5), rr = r & 15, cc = c & 31, ob = rr * 64 + cc * 2; return st * 1024 + (ob ^ (((ob >> 9) & 1) << 5)); }
__host__ __device__ __forceinline__ void stage_rc(int b, int& R, int& C) { const int st = b / 1024, sb = b % 1024, swz = sb ^ (((sb >> 9) & 1) << 5); R = (st >> 1) * 16 + swz / 64; C = (st & 1) * 32 + (swz % 64) / 2; }
__host__ __device__ __forceinline__ int perm32(int rho) { const int n = rho >> 4, i = rho & 15; return 8 * (i >> 2) + 4 * n + (i & 3); }

struct Unit { int pm, pn; };
struct Gemm { const bf16_t* A; const bf16_t* Bt; int M, N, K; int kt0 = 0, ktn = 0; };

struct StaticOrder {
    int nM, nN, nwg, G, c;
    __host__ __device__ void init(int M, int N, int G_, int c_) { nM = M / BM; nN = N / BM; nwg = nM * nN; G = G_; c = c_; }
    __host__ __device__ bool next(int i, Unit& u) const {
        const long L = (long)i * G + c; if (L >= nwg) return false;
        int wgid = (int)L; { const int q = nwg / NXCD, r = nwg % NXCD, xcd = wgid % NXCD, off = wgid / NXCD; wgid = (xcd < r ? xcd * (q + 1) : r * (q + 1) + (xcd - r) * q) + off; }
        const int nig = WGM * nN, gid = wgid / nig, fm = gid * WGM, gsz = (nM - fm) < WGM ? (nM - fm) : WGM;
        u.pm = fm + ((wgid % nig) % gsz); u.pn = (wgid % nig) / gsz; return true;
    }
    __device__ __forceinline__ void a_ready(const Unit&) const {}
    __device__ __forceinline__ void done(const Unit&) const {}
};

struct StaticOrderOff : StaticOrder {
    int pm0;
    __host__ __device__ bool next(int i, Unit& u) const { const bool r = StaticOrder::next(i, u); u.pm += pm0; return r; }
};
__device__ __forceinline__ unsigned cvt_pk_bf16(float lo, float hi) { unsigned r; asm volatile("v_cvt_pk_bf16_f32 %0, %1, %2" : "=v"(r) : "v"(lo), "v"(hi)); return r; }
typedef float f32x2 __attribute__((ext_vector_type(2)));
constexpr float QSCALE = 0.125f * 1.4426950408889634f;

__device__ __forceinline__ float clamp448(float v) { return __builtin_fminf(__builtin_fmaxf(v, -448.0f), 448.0f); }
__device__ __forceinline__ unsigned pk4_fp8(float a, float b, float c, float d) { int w = 0; w = __builtin_amdgcn_cvt_pk_fp8_f32(clamp448(a), clamp448(b), w, false); w = __builtin_amdgcn_cvt_pk_fp8_f32(clamp448(c), clamp448(d), w, true); return (unsigned)w; }
struct EpiResid {
    static constexpr bool PERM = false, AFTER_DRAIN = false;
    const float* base_lat; const float* base_ctx; float* out_lat; float* out_ctx; const float* gate; float s;
    __device__ __forceinline__ void operator()(const f32x4 (&acc)[2][2][4][2], const Unit& u, int wr, int wc, int fr, int fq) const {
        const bool lat = u.pm < 128;
        const int br = lat ? (u.pm >> 3) : 16;
        const size_t toff = (size_t)(lat ? u.pm : u.pm - 128) * (256 * 1024);
        const float* bs = (lat ? base_lat : base_ctx) + toff; float* os = (lat ? out_lat : out_ctx) + toff;
        const float* gp = gate + br * 6144;
        const int col0 = u.pn * BM + wc * 32 + 4 * fq;
        f32x4 gv[2][2];
#pragma unroll
        for (int bj = 0; bj < 2; ++bj)
#pragma unroll
            for (int n = 0; n < 2; ++n) gv[bj][n] = *(const f32x4*)(gp + col0 + bj * HALF + n * 16) * s;
        f32x4 b[3][2][2];
#define PG8_LDRES(it, buf) do { const size_t off_ = (size_t)(((it) >> 2) * HALF + wr * 64 + ((it) & 3) * 16 + fr) * 1024 + col0; \
            _Pragma("unroll") for (int bj = 0; bj < 2; ++bj) _Pragma("unroll") for (int n = 0; n < 2; ++n) b[buf][bj][n] = *(const f32x4*)(bs + off_ + bj * HALF + n * 16); } while (0)
        PG8_LDRES(0, 0); PG8_LDRES(1, 1);
#pragma unroll
        for (int it = 0; it < 8; ++it) { const int ai = it >> 2, m = it & 3; const size_t off = (size_t)(ai * HALF + wr * 64 + m * 16 + fr) * 1024 + col0;
                if (it + 2 < 8) PG8_LDRES(it + 2, (it + 2) % 3);
#pragma unroll
                for (int bj = 0; bj < 2; ++bj)
#pragma unroll
                    for (int n = 0; n < 2; ++n) *(f32x4*)(os + off + bj * HALF + n * 16) = b[it % 3][bj][n] + gv[bj][n] * acc[ai][bj][m][n];
                asm volatile("" ::: "memory"); }
#undef PG8_LDRES
    }
};

template <bool A8 = false> struct EpiResidNT {
    static constexpr bool PERM = false, AFTER_DRAIN = false;
    const float* base_lat; const float* base_ctx; float* out_lat; float* out_ctx; const float* gate;
    bf16_t* An; const float* ngain; const float* nscale; float* ssq; float s; int mt;
    __device__ __forceinline__ void operator()(const f32x4 (&acc)[2][2][4][2], const Unit& u, int wr, int wc, int fr, int fq) const {
        const bool lat = u.pm < 128;
        const int br = lat ? (u.pm >> 3) : 16;
        const size_t toff = (size_t)(lat ? u.pm : u.pm - 128) * (256 * 1024);
        const float* bs = (lat ? base_lat : base_ctx) + toff; float* os = (lat ? out_lat : out_ctx) + toff;
        const float* gp = gate + br * 6144; const float* sp = nscale + br * 6144;
        const int col0 = u.pn * BM + wc * 32 + 4 * fq;
        f32x4 gv[2][2], uv[2][2], sv[2][2];
#pragma unroll
        for (int bj = 0; bj < 2; ++bj)
#pragma unroll
            for (int n = 0; n < 2; ++n) { gv[bj][n] = *(const f32x4*)(gp + col0 + bj * HALF + n * 16); uv[bj][n] = *(const f32x4*)(ngain + col0 + bj * HALF + n * 16); sv[bj][n] = *(const f32x4*)(sp + col0 + bj * HALF + n * 16); }
        asm volatile("" : "+v"(gv[0][0]), "+v"(gv[0][1]), "+v"(gv[1][0]), "+v"(gv[1][1]), "+v"(uv[0][0]), "+v"(uv[0][1]), "+v"(uv[1][0]), "+v"(uv[1][1]), "+v"(sv[0][0]), "+v"(sv[0][1]), "+v"(sv[1][0]), "+v"(sv[1][1]));
#pragma unroll
        for (int bj = 0; bj < 2; ++bj)
#pragma unroll
            for (int n = 0; n < 2; ++n) { gv[bj][n] = gv[bj][n] * s; uv[bj][n] = uv[bj][n] * (sv[bj][n] + 1.0f); }
        f32x4 b[3][2][2];
#define PG8_LDRES(it, buf) do { const size_t off_ = (size_t)(((it) >> 2) * HALF + wr * 64 + ((it) & 3) * 16 + fr) * 1024 + col0; \
            _Pragma("unroll") for (int bj = 0; bj < 2; ++bj) _Pragma("unroll") for (int n = 0; n < 2; ++n) b[buf][bj][n] = *(const f32x4*)(bs + off_ + bj * HALF + n * 16); } while (0)
        PG8_LDRES(0, 0); PG8_LDRES(1, 1);
#pragma unroll
        for (int it = 0; it < 8; ++it) { const int ai = it >> 2, m = it & 3; const int rl = ai * HALF + wr * 64 + m * 16 + fr; const size_t off = (size_t)rl * 1024 + col0; const int rowg = u.pm * BM + rl;
                if (it + 2 < 8) PG8_LDRES(it + 2, (it + 2) % 3);
                bf16_t* ap = An + (size_t)rowg * 1024 + col0; float ss = 0.f;
#pragma unroll
                for (int bj = 0; bj < 2; ++bj)
#pragma unroll
                    for (int n = 0; n < 2; ++n) { const f32x4 x = b[it % 3][bj][n] + gv[bj][n] * acc[ai][bj][m][n]; *(f32x4*)(os + off + bj * HALF + n * 16) = x;
                        const f32x4 a = x * uv[bj][n];
                        if constexpr (A8) *(unsigned*)((unsigned char*)An + (size_t)rowg * 1024 + col0 + bj * HALF + n * 16) = pk4_fp8(a[0], a[1], a[2], a[3]);
                        else { u32x2 w; w.x = cvt_pk_bf16(a[0], a[1]); w.y = cvt_pk_bf16(a[2], a[3]); *(u32x2*)(ap + bj * HALF + n * 16) = w; }
                        ss += (x[0] * x[0] + x[1] * x[1]) + (x[2] * x[2] + x[3] * x[3]); }
                ss += xl::swz_xor<16>(ss); ss = xl::half_sum(ss);
                if (fq == 0) ssq[(size_t)(u.pn * 4 + wc) * mt + rowg] = ss;
                asm volatile("" ::: "memory"); }
#undef PG8_LDRES
    }
};
typedef EpiResidNT<false> EpiResidN;

__device__ __forceinline__ void rows_rstd(float (&rs)[2][4], const float* ssq, int mt, int row0, int fq) {
    float v[8][4];
#pragma unroll
    for (int i = 0; i < 8; ++i) { const float* p = ssq + (size_t)(4 * fq) * mt + row0 + (i >> 2) * HALF + (i & 3) * 16;
        v[i][0] = p[0]; v[i][1] = p[mt]; v[i][2] = p[2 * (size_t)mt]; v[i][3] = p[3 * (size_t)mt]; }
    asm volatile("" : "+v"(v[0][0]), "+v"(v[0][1]), "+v"(v[0][2]), "+v"(v[0][3]), "+v"(v[1][0]), "+v"(v[1][1]), "+v"(v[1][2]), "+v"(v[1][3]), "+v"(v[2][0]), "+v"(v[2][1]), "+v"(v[2][2]), "+v"(v[2][3]), "+v"(v[3][0]), "+v"(v[3][1]), "+v"(v[3][2]), "+v"(v[3][3]));
    asm volatile("" : "+v"(v[4][0]), "+v"(v[4][1]), "+v"(v[4][2]), "+v"(v[4][3]), "+v"(v[5][0]), "+v"(v[5][1]), "+v"(v[5][2]), "+v"(v[5][3]), "+v"(v[6][0]), "+v"(v[6][1]), "+v"(v[6][2]), "+v"(v[6][3]), "+v"(v[7][0]), "+v"(v[7][1]), "+v"(v[7][2]), "+v"(v[7][3]));
#pragma unroll
    for (int i = 0; i < 8; ++i) { float s = (v[i][0] + v[i][1]) + (v[i][2] + v[i][3]);
        s += xl::swz_xor<16>(s); s = xl::half_sum(s);
        rs[i >> 2][i & 3] = __builtin_amdgcn_rsqf(s * (1.0f / 1024.0f) + 1e-6f); }
}

__device__ __forceinline__ float silu_mul_s(float g, float u, float c1, float c2) { return (g * u) * __builtin_amdgcn_rcpf(__builtin_fmaf(__builtin_amdgcn_exp2f(g * c1), c2, c2)); }
__device__ __forceinline__ float silu_mul(float g, float u) { return g * __builtin_amdgcn_rcpf(1.0f + __builtin_amdgcn_exp2f(-1.4426950408889634f * g)) * u; }
struct EpiSwiGLU {
    static constexpr bool PERM = true, AFTER_DRAIN = false;
    bf16_t* O; int ldc; int row_off; const PG8_LAS int* tile_e; int nN;
    __device__ __forceinline__ void operator()(const f32x4 (&acc)[2][2][4][2], const Unit& u, int wr, int wc, int fr, int fq) const {
        int pnl = u.pn; if (tile_e) pnl -= tile_e[u.pm] * nN;
        const int row0 = u.pm * BM + wr * 64 + fr - row_off, col0 = pnl * HALF + wc * 32 + 8 * fq;
#pragma unroll
        for (int ai = 0; ai < 2; ++ai)
#pragma unroll
            for (int m = 0; m < 4; ++m) { bf16_t* rowp = O + (size_t)(row0 + ai * HALF + m * 16) * ldc + col0;
                const f32x4 g0 = acc[ai][0][m][0], g1 = acc[ai][0][m][1], u0 = acc[ai][1][m][0], u1 = acc[ai][1][m][1];
                u32x4 w; w.x = cvt_pk_bf16(silu_mul(g0[0], u0[0]), silu_mul(g0[1], u0[1])); w.y = cvt_pk_bf16(silu_mul(g0[2], u0[2]), silu_mul(g0[3], u0[3]));
                w.z = cvt_pk_bf16(silu_mul(g1[0], u1[0]), silu_mul(g1[1], u1[1])); w.w = cvt_pk_bf16(silu_mul(g1[2], u1[2]), silu_mul(g1[3], u1[3]));
                *(u32x4*)rowp = w; }
    }
};

struct EpiBf16Grp {
    static constexpr bool PERM = true, AFTER_DRAIN = false;
    bf16_t* O; const PG8_LAS int* tile_e; int nN;
    __device__ __forceinline__ void operator()(const f32x4 (&acc)[2][2][4][2], const Unit& u, int wr, int wc, int fr, int fq) const {
        const int pnl = u.pn - tile_e[u.pm] * nN;
        const int row0 = u.pm * BM + wr * 64 + fr, col0 = pnl * BM + wc * 32 + 8 * fq;
#pragma unroll
        for (int ai = 0; ai < 2; ++ai)
#pragma unroll
            for (int m = 0; m < 4; ++m) { bf16_t* rowp = O + (size_t)(row0 + ai * HALF + m * 16) * 1024 + col0;
#pragma unroll
                for (int bj = 0; bj < 2; ++bj) { const f32x4 v0 = acc[ai][bj][m][0], v1 = acc[ai][bj][m][1];
                    u32x4 w; w.x = cvt_pk_bf16(v0[0], v0[1]); w.y = cvt_pk_bf16(v0[2], v0[3]); w.z = cvt_pk_bf16(v1[0], v1[1]); w.w = cvt_pk_bf16(v1[2], v1[3]);
                    *(u32x4*)(rowp + bj * HALF) = w; } }
    }
};

template <bool ROPE, bool NRM = false, bool QK8 = false, bool VT8 = false> struct EpiQKV {
    static constexpr bool PERM = true, AFTER_DRAIN = false;
    bf16_t* Q; size_t stride; const float* rope; const float* ssq; int mt; const float* cvec; int cn; float s = 1.0f; unsigned char* q8 = nullptr; size_t stride8 = 0; unsigned char* vt = nullptr; PG8_LAS unsigned char* vscr = nullptr;
    __device__ __forceinline__ void operator()(const f32x4 (&acc)[2][2][4][2], const Unit& u, int wr, int wc, int fr, int fq) const {
        const int t = u.pn >> 2, colt = (u.pn & 3) * BM;
        bf16_t* base = Q + (size_t)t * stride;
        const float sc = ((t == 0) ? QSCALE * (QK8 ? 8.0f : 1.0f) : 1.0f) * (NRM ? 1.0f : s);
        const int row0 = u.pm * BM + wr * 64 + fr, col0 = colt + wc * 32 + 8 * fq;
        const bool do_rope = ROPE && t < 2 && u.pm < 128;
        float rs[2][4]; f32x4 cv[2][2];
        if constexpr (NRM) { rows_rstd(rs, ssq, mt, row0, fq);
#pragma unroll
            for (int i_ = 0; i_ < 8; ++i_) rs[i_ >> 2][i_ & 3] *= s; const float* cp = cvec + (size_t)((u.pm < 128) ? (u.pm >> 3) : 16) * cn + u.pn * BM + wc * 32 + 8 * fq;
            cv[0][0] = *(const f32x4*)(cp); cv[0][1] = *(const f32x4*)(cp + 4); cv[1][0] = *(const f32x4*)(cp + HALF); cv[1][1] = *(const f32x4*)(cp + HALF + 4); }
        if (VT8 && t == 2) {
            PG8_LAS unsigned char* vs = vscr + (wr * 4 + wc) * 2048;
            int lx; asm volatile("v_mbcnt_lo_u32_b32 %0, -1, 0\n\tv_mbcnt_hi_u32_b32 %0, -1, %0" : "=v"(lx));
#pragma unroll
            for (int ai = 0; ai < 2; ++ai) { const int rg0 = u.pm * BM + ai * HALF + wr * 64;
                const int bb = (rg0 < 32768) ? (rg0 >> 11) : ((rg0 - 32768) >> 8), T = (rg0 < 32768) ? ((rg0 & 2047) >> 6) : (32 + (((rg0 - 32768) & 255) >> 6));
#pragma unroll
                for (int bj = 0; bj < 2; ++bj) { const int colw = colt + bj * HALF + wc * 32;
#pragma unroll
                    for (int m = 0; m < 4; ++m) { const int k = m * 16 + fr, pos = ((k >> 2) & 1) * 32 + (k >> 5) * 16 + ((k >> 3) & 3) * 4 + (k & 3);
                        f32x4 v0 = acc[ai][bj][m][0], v1 = acc[ai][bj][m][1];
                        if constexpr (NRM) { v0 = v0 * rs[ai][m] + cv[bj][0]; v1 = v1 * rs[ai][m] + cv[bj][1]; } else { v0 = v0 * s; v1 = v1 * s; }
                        const unsigned w0 = pk4_fp8(v0[0], v0[1], v0[2], v0[3]), w1 = pk4_fp8(v1[0], v1[1], v1[2], v1[3]);
#pragma unroll
                        for (int e = 0; e < 4; ++e) { vs[(8 * fq + e) * 64 + pos] = (unsigned char)(w0 >> (8 * e)); vs[(8 * fq + e + 4) * 64 + pos] = (unsigned char)(w1 >> (8 * e)); } }
                    asm volatile("s_waitcnt lgkmcnt(0)" ::: "memory");
                    const u32x4 x0 = *(const PG8_LAS u32x4*)(vs + (lx >> 1) * 64 + (lx & 1) * 32), x1 = *(const PG8_LAS u32x4*)(vs + (lx >> 1) * 64 + (lx & 1) * 32 + 16);
                    unsigned char* vp = vt + ((size_t)((bb * 8 + (colw >> 7)) * 128 + (colw & 127) + (lx >> 1)) * 36 + T) * 64 + (lx & 1) * 32;
                    *(u32x4*)vp = x0; *(u32x4*)(vp + 16) = x1;
                    asm volatile("s_waitcnt lgkmcnt(0)" ::: "memory"); } }
            return;
        }
#pragma unroll
        for (int ai = 0; ai < 2; ++ai)
#pragma unroll
            for (int m = 0; m < 4; ++m) { const int row = row0 + ai * HALF + m * 16; bf16_t* rowp = base + (size_t)row * 1024 + col0;
                f32x4 cs[4];
                if (do_rope) { const int tok = row & 2047, pos = (wc & 1) ? (tok & 63) : (tok >> 6); const f32x4* cp = (const f32x4*)(rope + (pos * 16 + 8 * (fq & 1)) * 2);
                    cs[0] = cp[0]; cs[1] = cp[1]; cs[2] = cp[2]; cs[3] = cp[3]; }
#pragma unroll
                for (int bj = 0; bj < 2; ++bj) { f32x4 v0 = acc[ai][bj][m][0], v1 = acc[ai][bj][m][1];
                    if constexpr (NRM) { v0 = v0 * rs[ai][m] + cv[bj][0]; v1 = v1 * rs[ai][m] + cv[bj][1]; }
                    if (do_rope) {
                        f32x4 p0, p1;
#pragma unroll
                        for (int j = 0; j < 4; ++j) { p0[j] = xl::other_half(v0[j]); p1[j] = xl::other_half(v1[j]); }
                        const float sg = (fq < 2) ? -1.0f : 1.0f;
                        v0[0] = v0[0] * cs[0][0] + sg * p0[0] * cs[0][1]; v0[1] = v0[1] * cs[0][2] + sg * p0[1] * cs[0][3];
                        v0[2] = v0[2] * cs[1][0] + sg * p0[2] * cs[1][1]; v0[3] = v0[3] * cs[1][2] + sg * p0[3] * cs[1][3];
                        v1[0] = v1[0] * cs[2][0] + sg * p1[0] * cs[2][1]; v1[1] = v1[1] * cs[2][2] + sg * p1[1] * cs[2][3];
                        v1[2] = v1[2] * cs[3][0] + sg * p1[2] * cs[3][1]; v1[3] = v1[3] * cs[3][2] + sg * p1[3] * cs[3][3];
                    }
                    v0 = v0 * sc; v1 = v1 * sc;
                    if (QK8 && t < 2) { u32x2 w8; w8.x = pk4_fp8(v0[0], v0[1], v0[2], v0[3]); w8.y = pk4_fp8(v1[0], v1[1], v1[2], v1[3]); *(u32x2*)(q8 + (size_t)t * stride8 + (size_t)row * 1024 + col0 + bj * HALF) = w8; }
                    else { u32x4 w; w.x = cvt_pk_bf16(v0[0], v0[1]); w.y = cvt_pk_bf16(v0[2], v0[3]); w.z = cvt_pk_bf16(v1[0], v1[1]); w.w = cvt_pk_bf16(v1[2], v1[3]);
                    *(u32x4*)(rowp + bj * HALF) = w; } } }
    }
};

template <int XE = 0> struct EpiSwiGLU8T {
    static constexpr bool PERM = true, AFTER_DRAIN = false;
    unsigned char* O; int ldc; int row_off; const PG8_LAS int* tile_e; int nN; float s;
    __device__ __forceinline__ void operator()(const f32x4 (&acc)[2][2][4][2], const Unit& u, int wr, int wc, int fr, int fq) const {
        int pnl = u.pn; if (tile_e) pnl -= tile_e[u.pm] * nN;
        const int row0 = u.pm * BM + wr * 64 + fr - row_off, col0 = pnl * HALF + wc * 32 + 8 * fq;
#pragma unroll
        for (int ai = 0; ai < 2; ++ai)
#pragma unroll
            for (int m = 0; m < 4; ++m) { unsigned char* rowp = O + (size_t)(row0 + ai * HALF + m * 16) * ldc + col0;
                const f32x4 g0 = acc[ai][0][m][0] * s, g1 = acc[ai][0][m][1] * s, u0 = acc[ai][1][m][0] * s, u1 = acc[ai][1][m][1] * s;
                u32x2 w; if (XE == 2) { const float c1 = -1.4426950408889634f * s, c2 = 1.0f / (s * s); const f32x4 a0 = acc[ai][0][m][0], a1 = acc[ai][0][m][1], b0 = acc[ai][1][m][0], b1 = acc[ai][1][m][1];
                    w.x = pk4_fp8(silu_mul_s(a0[0], b0[0], c1, c2), silu_mul_s(a0[1], b0[1], c1, c2), silu_mul_s(a0[2], b0[2], c1, c2), silu_mul_s(a0[3], b0[3], c1, c2));
                    w.y = pk4_fp8(silu_mul_s(a1[0], b1[0], c1, c2), silu_mul_s(a1[1], b1[1], c1, c2), silu_mul_s(a1[2], b1[2], c1, c2), silu_mul_s(a1[3], b1[3], c1, c2)); }
                else if (XE == 1) { w.x = pk4_fp8(g0[0] * u0[0], g0[1] * u0[1], g0[2] * u0[2], g0[3] * u0[3]); w.y = pk4_fp8(g1[0] * u1[0], g1[1] * u1[1], g1[2] * u1[2], g1[3] * u1[3]); } else {
                w.x = pk4_fp8(silu_mul(g0[0], u0[0]), silu_mul(g0[1], u0[1]), silu_mul(g0[2], u0[2]), silu_mul(g0[3], u0[3]));
                w.y = pk4_fp8(silu_mul(g1[0], u1[0]), silu_mul(g1[1], u1[1]), silu_mul(g1[2], u1[2]), silu_mul(g1[3], u1[3])); }
                *(u32x2*)rowp = w; }
    }
};
typedef EpiSwiGLU8T<0> EpiSwiGLU8;

struct EpiSwiGLU8N {
    static constexpr bool PERM = true, AFTER_DRAIN = false;
    unsigned char* O; int ldc; const float* ssq; int mt; const float* cvec; int cn; float s = 1.0f;
    __device__ __forceinline__ void operator()(const f32x4 (&acc)[2][2][4][2], const Unit& u, int wr, int wc, int fr, int fq) const {
        const int br = (u.pm < 128) ? (u.pm >> 3) : 16;
        const int row0 = u.pm * BM + wr * 64 + fr, col0 = u.pn * HALF + wc * 32 + 8 * fq;
        const float* cp = cvec + (size_t)br * cn + u.pn * BM + wc * 32 + 8 * fq;
        f32x4 cg0 = *(const f32x4*)(cp), cg1 = *(const f32x4*)(cp + 4), cu0 = *(const f32x4*)(cp + HALF), cu1 = *(const f32x4*)(cp + HALF + 4);
        float rs[2][4]; rows_rstd(rs, ssq, mt, row0, fq);
        asm volatile("" : "+v"(cg0), "+v"(cg1), "+v"(cu0), "+v"(cu1));
#pragma unroll
        for (int ai = 0; ai < 2; ++ai)
#pragma unroll
            for (int m = 0; m < 4; ++m) { unsigned char* rowp = O + (size_t)(row0 + ai * HALF + m * 16) * ldc + col0; const float r = rs[ai][m] * s;
                const f32x4 g0 = acc[ai][0][m][0] * r + cg0, g1 = acc[ai][0][m][1] * r + cg1, u0 = acc[ai][1][m][0] * r + cu0, u1 = acc[ai][1][m][1] * r + cu1;
                u32x2 w; w.x = pk4_fp8(silu_mul(g0[0], u0[0]), silu_mul(g0[1], u0[1]), silu_mul(g0[2], u0[2]), silu_mul(g0[3], u0[3]));
                w.y = pk4_fp8(silu_mul(g1[0], u1[0]), silu_mul(g1[1], u1[1]), silu_mul(g1[2], u1[2]), silu_mul(g1[3], u1[3]));
                *(u32x2*)rowp = w; }
    }
};
struct EpiBf16GrpS {
    static constexpr bool PERM = true, AFTER_DRAIN = false;
    bf16_t* O; const PG8_LAS int* tile_e; int nN; float s;
    __device__ __forceinline__ void operator()(const f32x4 (&acc)[2][2][4][2], const Unit& u, int wr, int wc, int fr, int fq) const {
        const int pnl = u.pn - tile_e[u.pm] * nN;
        const int row0 = u.pm * BM + wr * 64 + fr, col0 = pnl * BM + wc * 32 + 8 * fq;
#pragma unroll
        for (int ai = 0; ai < 2; ++ai)
#pragma unroll
            for (int m = 0; m < 4; ++m) { bf16_t* rowp = O + (size_t)(row0 + ai * HALF + m * 16) * 1024 + col0;
#pragma unroll
                for (int bj = 0; bj < 2; ++bj) { const f32x4 v0 = acc[ai][bj][m][0] * s, v1 = acc[ai][bj][m][1] * s;
                    u32x4 w; w.x = cvt_pk_bf16(v0[0], v0[1]); w.y = cvt_pk_bf16(v0[2], v0[3]); w.z = cvt_pk_bf16(v1[0], v1[1]); w.w = cvt_pk_bf16(v1[2], v1[3]);
                    *(u32x4*)(rowp + bj * HALF) = w; } }
    }
};

struct EpiPart {
    static constexpr bool PERM = true, AFTER_DRAIN = false;
    float* P; float s;
    __device__ __forceinline__ void operator()(const f32x4 (&acc)[2][2][4][2], const Unit&, int wr, int wc, int fr, int fq) const {
#pragma unroll
        for (int ai = 0; ai < 2; ++ai)
#pragma unroll
            for (int m = 0; m < 4; ++m) { float* rowp = P + (size_t)(ai * HALF + wr * 64 + m * 16 + fr) * 256 + wc * 32 + 8 * fq;
#pragma unroll
                for (int bj = 0; bj < 2; ++bj) { *(f32x4*)(rowp + bj * HALF) = acc[ai][bj][m][0] * s; *(f32x4*)(rowp + bj * HALF + 4) = acc[ai][bj][m][1] * s; } }
    }
};

struct MoeOrder {
    int T, nN, G, c, Lcap; const PG8_LAS int* tile_e;
    __device__ __forceinline__ void init(int T_, int nN_, int G_, int c_, const PG8_LAS int* te) { T = T_; nN = nN_; G = G_; c = c_; tile_e = te; Lcap = T_ * nN_; }
    __device__ __forceinline__ bool next(int i, Unit& u) const {
        const int L = i * G + c; if (L >= Lcap) return false;
        const int Tf = T & ~7, nfull = Tf * nN; int pm, pl;
        if (L < nfull) { const int blk = L >> 5, r = L & 31, nb = nN >> 2; pm = (blk / nb) * 8 + (r & 7); pl = (blk % nb) * 4 + (r >> 3); }
        else { const int Lr = L - nfull; pm = Tf + Lr / nN; pl = Lr % nN; }
        u.pm = pm; u.pn = tile_e[pm] * nN + pl; return true;
    }
    __device__ __forceinline__ void a_ready(const Unit&) const {}
    __device__ __forceinline__ void done(const Unit&) const {}
};

template <class Epi, class Sched, bool ALIGN_EPI = false, bool SP2 = false, bool FP8 = false>
__device__ __forceinline__ void gemm_phase(PG8_LAS unsigned char* lds, const Gemm g, const Sched& S, const Epi& E, int tid_in) {
    int tid_l = tid_in; asm volatile("" : "+v"(tid_l));
    const int tid = tid_l, wid = __builtin_amdgcn_readfirstlane(tid >> 6), lane = tid & 63, wr = wid >> 2, wc = wid & 3, fr = lane & 15, fq = lane >> 4;
    const int K = g.K, nt = g.ktn ? g.ktn : K / BK;
    unsigned voffA[1], voffB[1];
    { int R, C; stage_rc(tid * 16, R, C); const int Rb = Epi::PERM ? ((R & ~31) + perm32(R & 31)) : R;
        voffA[0] = (unsigned)(R * K + C) * 2u; voffB[0] = (unsigned)(Rb * K + C) * 2u; }
    const size_t rstep64 = (size_t)64 * K * 2;
    const size_t kstep = (size_t)(BK * 2);
    const size_t hstep = (size_t)HALF * K * 2;
    const size_t tstep = 2 * hstep;
    const unsigned ldsw = (unsigned)wid * 1024u;
    const unsigned ldsbase = (unsigned)__builtin_amdgcn_readfirstlane((int)((unsigned)(uintptr_t)lds + ldsw));
    const int aoff = lds_byte(wr * 64 + fr, fq * 8), boff = lds_byte(wc * 32 + fr, fq * 8);
#define PG8_SA(b, h) (((b) * 2 + (h)) * HTB)
#define PG8_SB(b, h) ((4 + (b) * 2 + (h)) * HTB)
#define PG8_DMA1(ldsimm, gptr, vo) do { unsigned keep_; asm volatile("s_mov_b32 %0, m0\n\ts_add_i32 m0, %3, %4\n\ts_nop 0\n\tglobal_load_lds_dwordx4 %1, %2\n\ts_mov_b32 m0, %0" \
        : "=&s"(keep_) : "v"(vo), "s"((const char*)(gptr)), "s"(ldsbase), "n"(ldsimm) : "memory", "scc"); } while (0)
#define PG8_STAGE(bufoff, gbase, voff) do { PG8_DMA1((bufoff), (gbase), (voff)[0]); PG8_DMA1((bufoff) + 8192, (const char*)(gbase) + rstep64, (voff)[0]); } while (0)
#define PG8_LDA(dst, b, h) do { if constexpr (FP8) { _Pragma("unroll") for (int m = 0; m < 4; ++m) dst##8[m] = __builtin_shufflevector(*(const PG8_LAS i32x4_t*)(lds + PG8_SA(b, h) + aoff + m * 2048), *(const PG8_LAS i32x4_t*)(lds + PG8_SA(b, h) + aoff + m * 2048 + 1024), 0, 1, 2, 3, 4, 5, 6, 7); } \
        else { _Pragma("unroll") for (int m = 0; m < 4; ++m) _Pragma("unroll") for (int k = 0; k < 2; ++k) dst[m][k] = *(const PG8_LAS bf16x8*)(lds + PG8_SA(b, h) + aoff + m * 2048 + k * 1024); } } while (0)
#define PG8_LDB(dst, b, h) do { if constexpr (FP8) { _Pragma("unroll") for (int n = 0; n < 2; ++n) dst##8[n] = __builtin_shufflevector(*(const PG8_LAS i32x4_t*)(lds + PG8_SB(b, h) + boff + n * 2048), *(const PG8_LAS i32x4_t*)(lds + PG8_SB(b, h) + boff + n * 2048 + 1024), 0, 1, 2, 3, 4, 5, 6, 7); } \
        else { _Pragma("unroll") for (int n = 0; n < 2; ++n) _Pragma("unroll") for (int k = 0; k < 2; ++k) dst[n][k] = *(const PG8_LAS bf16x8*)(lds + PG8_SB(b, h) + boff + n * 2048 + k * 1024); } } while (0)
#define PG8_MMA(ai, bj, At, Bt) do { __builtin_amdgcn_s_setprio(1); \
        if constexpr (FP8) { _Pragma("unroll") for (int m = 0; m < 4; ++m) _Pragma("unroll") for (int n = 0; n < 2; ++n) \
            acc[ai][bj][m][n] = __builtin_amdgcn_mfma_scale_f32_16x16x128_f8f6f4(Bt##8[n], At##8[m], acc[ai][bj][m][n], 0, 0, 0, 0x7f7f7f7f, 0, 0x7f7f7f7f); } \
        else { _Pragma("unroll") for (int m = 0; m < 4; ++m) _Pragma("unroll") for (int n = 0; n < 2; ++n) _Pragma("unroll") for (int k = 0; k < 2; ++k) \
            acc[ai][bj][m][n] = __builtin_amdgcn_mfma_f32_16x16x32_bf16(Bt[n][k], At[m][k], acc[ai][bj][m][n], 0, 0, 0); } \
        __builtin_amdgcn_s_setprio(0); } while (0)
#define PG8_WAIT_V(n) asm volatile("s_waitcnt vmcnt(" #n ")" ::: "memory")
#define PG8_WAIT_L(n) asm volatile("s_waitcnt lgkmcnt(" #n ")" ::: "memory")
#define PG8_BAR __builtin_amdgcn_s_barrier()
#define PG8_SCHED __builtin_amdgcn_sched_barrier(0)
    Unit cur, nxt; int ui = 0;
    if (!S.next(0, cur)) return;
    f32x4 acc[2][2][4][2];
#pragma unroll
    for (int a = 0; a < 2; ++a)
#pragma unroll
        for (int b = 0; b < 2; ++b)
#pragma unroll
            for (int m = 0; m < 4; ++m)
#pragma unroll
                for (int n = 0; n < 2; ++n) acc[a][b][m][n] = (f32x4){0.f, 0.f, 0.f, 0.f};
    bf16x8 At[4][2], B0[2][2], B1[2][2]; i32x8_t At8[4], B08[2], B18[2];
    const size_t koff = (size_t)g.kt0 * kstep;
    const char* cA = (const char*)g.A + (size_t)cur.pm * tstep + koff; const char* cB = (const char*)g.Bt + (size_t)cur.pn * tstep + koff;
    S.a_ready(cur);
    if constexpr (SP2) {
        PG8_STAGE(PG8_SB(0, 0), cB, voffB); PG8_STAGE(PG8_SB(0, 1), cB + hstep, voffB); PG8_STAGE(PG8_SA(0, 0), cA, voffA); PG8_STAGE(PG8_SA(0, 1), cA + hstep, voffA);
        if (wr == 1) PG8_BAR;
        PG8_WAIT_V(2); PG8_BAR;
        PG8_STAGE(PG8_SB(1, 0), cB + kstep, voffB); PG8_STAGE(PG8_SA(1, 0), cA + kstep, voffA); PG8_STAGE(PG8_SB(1, 1), cB + hstep + kstep, voffB);
        PG8_WAIT_V(6); PG8_BAR;
    } else {
        PG8_STAGE(PG8_SB(0, 0), cB, voffB); PG8_STAGE(PG8_SA(0, 0), cA, voffA); PG8_STAGE(PG8_SB(0, 1), cB + hstep, voffB); PG8_STAGE(PG8_SA(0, 1), cA + hstep, voffA);
        if (wr == 1) PG8_BAR;
        PG8_WAIT_V(4); PG8_BAR;
        PG8_STAGE(PG8_SB(1, 0), cB + kstep, voffB); PG8_STAGE(PG8_SA(1, 0), cA + kstep, voffA); PG8_STAGE(PG8_SB(1, 1), cB + hstep + kstep, voffB);
        PG8_WAIT_V(6); PG8_BAR;
    }
    for (;;) {
        const bool has_next = S.next(ui + 1, nxt);
        const char* nA = has_next ? (const char*)g.A + (size_t)nxt.pm * tstep + koff : cA; const char* nB = has_next ? (const char*)g.Bt + (size_t)nxt.pn * tstep + koff : cB;
#pragma unroll 1
        for (int t = 0; t < nt; t += 2) {
            const bool last = (t == nt - 2);
            const char* a1 = cA + (size_t)(t + 1) * kstep;
            const char* a2 = last ? nA : cA + (size_t)(t + 2) * kstep; const char* b2 = last ? nB : cB + (size_t)(t + 2) * kstep;
            const char* a3 = a2 + kstep; const char* b3 = b2 + kstep;
            if (last && has_next) S.a_ready(nxt);
            if constexpr (SP2) {
            PG8_LDB(B0, 0, 0); PG8_LDB(B1, 0, 1); PG8_SCHED; PG8_LDA(At, 0, 0); PG8_STAGE(PG8_SA(1, 1), a1 + hstep, voffA);
            PG8_WAIT_V(8); PG8_WAIT_L(0); PG8_BAR; PG8_MMA(0, 0, At, B0); PG8_MMA(0, 1, At, B1); PG8_BAR; PG8_SCHED;
            PG8_LDA(At, 0, 1); PG8_STAGE(PG8_SB(0, 0), b2, voffB); PG8_STAGE(PG8_SB(0, 1), b2 + hstep, voffB); PG8_STAGE(PG8_SA(0, 0), a2, voffA);
            PG8_WAIT_V(8); PG8_WAIT_L(0); PG8_BAR; PG8_MMA(1, 0, At, B0); PG8_MMA(1, 1, At, B1); PG8_BAR; PG8_SCHED;
            PG8_LDB(B0, 1, 0); PG8_LDB(B1, 1, 1); PG8_SCHED; PG8_LDA(At, 1, 0); PG8_STAGE(PG8_SA(0, 1), a2 + hstep, voffA);
            PG8_WAIT_V(8); PG8_WAIT_L(0); PG8_BAR; PG8_MMA(0, 0, At, B0); PG8_MMA(0, 1, At, B1); PG8_BAR; PG8_SCHED;
            PG8_LDA(At, 1, 1); PG8_STAGE(PG8_SB(1, 0), b3, voffB); PG8_STAGE(PG8_SB(1, 1), b3 + hstep, voffB); PG8_STAGE(PG8_SA(1, 0), a3, voffA);
            PG8_WAIT_V(8); PG8_WAIT_L(0); PG8_BAR; PG8_MMA(1, 0, At, B0); PG8_MMA(1, 1, At, B1); PG8_BAR; PG8_SCHED;
            } else {
            PG8_LDB(B0, 0, 0); PG8_SCHED; PG8_LDA(At, 0, 0); PG8_STAGE(PG8_SA(1, 1), a1 + hstep, voffA);
            PG8_WAIT_L(8); PG8_BAR; PG8_WAIT_L(0); PG8_MMA(0, 0, At, B0); PG8_BAR; PG8_SCHED;
            PG8_LDB(B1, 0, 1); PG8_STAGE(PG8_SB(0, 0), b2, voffB);
            PG8_BAR; PG8_WAIT_L(0); PG8_MMA(0, 1, At, B1); PG8_BAR;
            PG8_LDA(At, 0, 1); PG8_STAGE(PG8_SA(0, 0), a2, voffA);
            PG8_BAR; PG8_WAIT_L(0); PG8_MMA(1, 0, At, B0); PG8_BAR; PG8_SCHED;
            PG8_STAGE(PG8_SB(0, 1), b2 + hstep, voffB);
            PG8_WAIT_V(6); PG8_BAR; PG8_MMA(1, 1, At, B1); PG8_BAR;
            PG8_LDB(B0, 1, 0); PG8_SCHED; PG8_LDA(At, 1, 0); PG8_STAGE(PG8_SA(0, 1), a2 + hstep, voffA);
            PG8_WAIT_L(8); PG8_BAR; PG8_WAIT_L(0); PG8_MMA(0, 0, At, B0); PG8_BAR; PG8_SCHED;
            PG8_LDB(B1, 1, 1); PG8_STAGE(PG8_SB(1, 0), b3, voffB);
            PG8_BAR; PG8_WAIT_L(0); PG8_MMA(0, 1, At, B1); PG8_BAR;
            PG8_LDA(At, 1, 1); PG8_STAGE(PG8_SA(1, 0), a3, voffA);
            PG8_BAR; PG8_WAIT_L(0); PG8_MMA(1, 0, At, B0); PG8_BAR; PG8_SCHED;
            PG8_STAGE(PG8_SB(1, 1), b3 + hstep, voffB);
            PG8_WAIT_V(6); PG8_BAR; PG8_MMA(1, 1, At, B1); PG8_BAR;
            }
        }
        if constexpr (ALIGN_EPI) { if (wr == 0) PG8_BAR; }
        if constexpr (!Epi::AFTER_DRAIN) { int laneE; asm volatile("v_mbcnt_lo_u32_b32 %0, -1, 0\n\tv_mbcnt_hi_u32_b32 %0, -1, %0" : "=v"(laneE)); const int frE = laneE & 15, fqE = laneE >> 4;
            E(acc, cur, wr, wc, frE, fqE); S.done(cur); }
        if (!has_next) break;
#pragma unroll
        for (int a = 0; a < 2; ++a)
#pragma unroll
            for (int b = 0; b < 2; ++b)
#pragma unroll
                for (int m = 0; m < 4; ++m)
#pragma unroll
                    for (int n = 0; n < 2; ++n) acc[a][b][m][n] = (f32x4){0.f, 0.f, 0.f, 0.f};
        cur = nxt; cA = nA; cB = nB; ++ui;
        if constexpr (ALIGN_EPI) { if (wr == 1) PG8_BAR; }
    }
    PG8_WAIT_V(0);
    if constexpr (!ALIGN_EPI) { if (wr == 0) PG8_BAR; }
    PG8_BAR;
    if constexpr (Epi::AFTER_DRAIN) { E.fused(acc, cur, wr, wc, fr, fq, lds, wid, lane); S.done(cur); }
#undef PG8_SA
#undef PG8_SB
#undef PG8_STAGE
#undef PG8_LDA
#undef PG8_LDB
#undef PG8_MMA
#undef PG8_WAIT_V
#undef PG8_WAIT_L
#undef PG8_BAR
#undef PG8_SCHED
}
}
namespace att {
#define ATT_LAS __attribute__((address_space(3)))
typedef float f32x16 __attribute__((ext_vector_type(16)));
typedef float f32x4 __attribute__((ext_vector_type(4)));
typedef short bf16x8 __attribute__((ext_vector_type(8)));
typedef short s16x4 __attribute__((ext_vector_type(4)));
typedef short v4i16_t __attribute__((ext_vector_type(4)));
typedef unsigned u32x4 __attribute__((ext_vector_type(4)));
typedef int i32x4q __attribute__((ext_vector_type(4)));
typedef int i32x8q __attribute__((ext_vector_type(8)));
typedef unsigned short bf16_t;
constexpr int PITCH = 1024;
constexpr float LOG2E = 1.4426950408889634f;
constexpr int L_K = 0, L_V = 49152, L_WSF = 81920, L_RPB = 81920 + 8 * 512, L_DMY = 81920 + 6144, L_QST = 81920 + 8192, L_NAV = 81920 + 8192, KBUF = 16384, VBUF = 16384;

__device__ __forceinline__ int crow(int r, int hi) { return (r & 3) + 8 * (r >> 2) + 4 * hi; }
__device__ __forceinline__ s16x4 vtr(const ATT_LAS char* p) { return __builtin_bit_cast(s16x4, __builtin_amdgcn_ds_read_tr16_b64_v4i16((ATT_LAS v4i16_t*)p)); }
__device__ __forceinline__ unsigned cvtpk(float lo, float hi) { unsigned r; asm volatile("v_cvt_pk_bf16_f32 %0, %1, %2" : "=v"(r) : "v"(lo), "v"(hi)); return r; }
__device__ __forceinline__ unsigned char f2f8(float f) { const float c = __builtin_fminf(__builtin_fmaxf(f, -448.0f), 448.0f); return (unsigned char)(__builtin_amdgcn_cvt_pk_fp8_f32(c, c, 0, false) & 0xff); }
__device__ __forceinline__ unsigned f2bf(float f) { unsigned u = __builtin_bit_cast(unsigned, f); return (u + 0x7fffu + ((u >> 16) & 1u)) >> 16; }
__device__ __forceinline__ void dma16(const void* g, ATT_LAS unsigned char* l) { unsigned keep; const unsigned dst = (unsigned)__builtin_amdgcn_readfirstlane((int)(unsigned)(uintptr_t)l);
    asm volatile("s_mov_b32 %0, m0\n\ts_mov_b32 m0, %2\n\ts_nop 0\n\tglobal_load_lds_dwordx4 %1, off\n\ts_mov_b32 m0, %0" : "=&s"(keep) : "v"(g), "s"(dst) : "memory"); }
#define ATT_LDSW() asm volatile("s_waitcnt lgkmcnt(0)" ::: "memory")
__device__ __forceinline__ void dma16s(const void* sbase, unsigned voff, ATT_LAS unsigned char* l) { unsigned keep; const unsigned dst = (unsigned)__builtin_amdgcn_readfirstlane((int)(unsigned)(uintptr_t)l);
    asm volatile("s_mov_b32 %0, m0\n\ts_mov_b32 m0, %3\n\ts_nop 0\n\tglobal_load_lds_dwordx4 %1, %2\n\ts_mov_b32 m0, %0" : "=&s"(keep) : "v"(voff), "s"(sbase), "s"(dst) : "memory"); }
using xl::swz_xor; using xl::half_max; using xl::half_sum;
#define ATT_IDS() int lane_l; asm volatile("v_mbcnt_lo_u32_b32 %0, -1, 0\n\tv_mbcnt_hi_u32_b32 %0, -1, %0" : "=v"(lane_l)); const int wid = wave_in, lane = lane_l, tid = wid * 64 + lane, r32 = lane & 31, hi = lane >> 5; (void)tid

__device__ __forceinline__ float max3f(float a, float b, float c) { float r; asm("v_max3_f32 %0, %1, %2, %3" : "=v"(r) : "v"(a), "v"(b), "v"(c)); return r; }
__device__ __forceinline__ float rowmax32(f32x16& p0, f32x16& p1) {
    asm volatile("s_nop 15\n\ts_nop 7" : "+v"(p0), "+v"(p1));
    float a = max3f(p0[0], p0[1], p1[0]), b = max3f(p0[2], p0[3], p1[1]); a = max3f(a, p1[2], p1[3]);
#pragma unroll
    for (int r = 4; r < 16; r += 4) { a = max3f(a, p0[r], p0[r + 1]); b = max3f(b, p0[r + 2], p0[r + 3]); a = max3f(a, p1[r], p1[r + 1]); b = max3f(b, p1[r + 2], p1[r + 3]); }
    float r; asm("v_max_f32_e32 %0, %1, %2" : "=v"(r) : "v"(a), "v"(b)); return r;
}
constexpr float SUM_BIG = 16777216.0f;
#define SM_EXPSUM8(P, Q, B, S) asm("v_exp_f32_e32 %0, %9\n\tv_exp_f32_e32 %1, %10\n\tv_exp_f32_e32 %2, %11\n\tv_add_f32_e32 %8, %0, %8\n\tv_exp_f32_e32 %3, %12\n\tv_add_f32_e32 %8, %1, %8\n\tv_exp_f32_e32 %4, %13\n\tv_add_f32_e32 %8, %2, %8\n\tv_exp_f32_e32 %5, %14\n\tv_add_f32_e32 %8, %3, %8\n\tv_exp_f32_e32 %6, %15\n\tv_add_f32_e32 %8, %4, %8\n\tv_exp_f32_e32 %7, %16\n\tv_add_f32_e32 %8, %5, %8\n\tv_add_f32_e32 %8, %6, %8\n\tv_add_f32_e32 %8, %7, %8" \
        : "=&v"(P[B]), "=&v"(P[B + 1]), "=&v"(P[B + 2]), "=&v"(P[B + 3]), "=&v"(P[B + 4]), "=&v"(P[B + 5]), "=&v"(P[B + 6]), "=&v"(P[B + 7]), "+v"(S) \
        : "v"(Q[B]), "v"(Q[B + 1]), "v"(Q[B + 2]), "v"(Q[B + 3]), "v"(Q[B + 4]), "v"(Q[B + 5]), "v"(Q[B + 6]), "v"(Q[B + 7]))
__device__ __forceinline__ bool softmax_fast(f32x16& p0, f32x16& p1, float& l, u32x4 (&pa)[4]) {
    asm volatile("s_nop 15\n\ts_nop 7" : "+v"(p0), "+v"(p1));
    float a[16], b[16]; float s = 0.f;
    SM_EXPSUM8(a, p0, 0, s); SM_EXPSUM8(a, p0, 8, s); SM_EXPSUM8(b, p1, 0, s); SM_EXPSUM8(b, p1, 8, s);
    if (__any(!(s < SUM_BIG))) return false;
    l += s;
    pa[0] = (u32x4){cvtpk(a[0], a[1]), cvtpk(a[2], a[3]), cvtpk(a[4], a[5]), cvtpk(a[6], a[7])};
    pa[1] = (u32x4){cvtpk(a[8], a[9]), cvtpk(a[10], a[11]), cvtpk(a[12], a[13]), cvtpk(a[14], a[15])};
    pa[2] = (u32x4){cvtpk(b[0], b[1]), cvtpk(b[2], b[3]), cvtpk(b[4], b[5]), cvtpk(b[6], b[7])};
    pa[3] = (u32x4){cvtpk(b[8], b[9]), cvtpk(b[10], b[11]), cvtpk(b[12], b[13]), cvtpk(b[14], b[15])};
    return true;
}
#define NA_KFRAG(kb) __builtin_shufflevector(*(const ATT_LAS i32x4q*)(kb), *(const ATT_LAS i32x4q*)((kb) + 1024), 0, 1, 2, 3, 4, 5, 6, 7)
__device__ __forceinline__ f32x16 mfma_qk8(const i32x8q k, const i32x8q q, const f32x16 c) { return __builtin_amdgcn_mfma_scale_f32_32x32x64_f8f6f4(k, q, c, 0, 0, 0, 0x7f7f7f7f, 0, 0x7c7c7c7c); }
constexpr float RESC_THR = 8.0f;
struct NoMask { __device__ __forceinline__ void operator()(f32x16&, f32x16&) const {} };
__host__ __device__ constexpr unsigned long long na_lane_mask(int r, int half, int c0) {
    unsigned long long mk = 0;
    for (int lane = 0; lane < 64; ++lane) { const int hi = lane >> 5, c = c0 + (lane & 31), kc = (r & 3) + 8 * (r >> 2) + 4 * hi + 32 * half;
        int ws = c - 8; ws = ws < 0 ? 0 : (ws > 48 ? 48 : ws);
        if (kc >= ws && kc < ws + 16) mk |= 1ull << lane; }
    return mk;
}
__device__ __forceinline__ float sel_mask(float v, unsigned long long mk) { float r; asm("v_cndmask_b32_e64 %0, %1, %2, %3" : "=v"(r) : "v"(-INFINITY), "v"(v), "s"(mk)); return r; }
struct NaMask {
    const ATT_LAS float* lbase; int c0;
    __device__ __forceinline__ void operator()(f32x16& p0, f32x16& p1) const {
        asm volatile("s_nop 15\n\ts_nop 7" : "+v"(p0), "+v"(p1));
#pragma unroll
        for (int r = 0; r < 16; ++r) {
            const int e = (r & 3) + 8 * (r >> 2);
            const float b0 = lbase[e], b1 = lbase[e + 32];
            const unsigned long long m0 = c0 ? na_lane_mask(r, 0, 32) : na_lane_mask(r, 0, 0), m1 = c0 ? na_lane_mask(r, 1, 32) : na_lane_mask(r, 1, 0);
            p0[r] = sel_mask(p0[r] + b0, m0);
            p1[r] = sel_mask(p1[r] + b1, m1);
        }
    }
};

template <int NDB, class Mask>
__device__ __forceinline__ void qk_step(const ATT_LAS unsigned char* Kimg, const i32x8q& qf, float& m, float& l, f32x16 (&o)[NDB], u32x4 (&pa)[4], ATT_LAS float* wsf, const Mask& mask, int r32, int hi) {
    f32x16 p0, p1;
#pragma unroll
    for (int r = 0; r < 16; ++r) { p0[r] = 0.f; p1[r] = 0.f; }
    const ATT_LAS unsigned char* kb = Kimg + hi * 2048 + r32 * 16;
    { const i32x8q k0 = NA_KFRAG(kb), k1 = NA_KFRAG(kb + 512); const f32x16 z = p0; p0 = mfma_qk8(k0, qf, z); p1 = mfma_qk8(k1, qf, z); }
    mask(p0, p1);
    float mx = rowmax32(p0, p1);
    mx = half_max(mx);
    const float mn = fmaxf(m, mx);
    if (__any(mx > m + RESC_THR)) {
        const float alpha = __builtin_amdgcn_exp2f(m - mn);
        l *= alpha; m = mn;
        int le_; asm volatile("v_mbcnt_lo_u32_b32 %0, -1, 0\n\tv_mbcnt_hi_u32_b32 %0, -1, %0" : "=v"(le_)); const int hi_ = le_ >> 5;
        if (le_ < 32) wsf[le_] = alpha;
        ATT_LDSW();
#pragma unroll
        for (int g = 0; g < 4; ++g) { const f32x4 a4 = *(const ATT_LAS f32x4*)(wsf + 8 * g + 4 * hi_);
#pragma unroll
            for (int db = 0; db < NDB; ++db) { o[db][4 * g] *= a4[0]; o[db][4 * g + 1] *= a4[1]; o[db][4 * g + 2] *= a4[2]; o[db][4 * g + 3] *= a4[3]; } }
        ATT_LDSW();
    }
    float s = 0.f;
#pragma unroll
    for (int r = 0; r < 16; ++r) { p0[r] = __builtin_amdgcn_exp2f(p0[r] - m); p1[r] = __builtin_amdgcn_exp2f(p1[r] - m); s += p0[r] + p1[r]; }
    l += s;
    pa[0] = (u32x4){cvtpk(p0[0], p0[1]), cvtpk(p0[2], p0[3]), cvtpk(p0[4], p0[5]), cvtpk(p0[6], p0[7])};
    pa[1] = (u32x4){cvtpk(p0[8], p0[9]), cvtpk(p0[10], p0[11]), cvtpk(p0[12], p0[13]), cvtpk(p0[14], p0[15])};
    pa[2] = (u32x4){cvtpk(p1[0], p1[1]), cvtpk(p1[2], p1[3]), cvtpk(p1[4], p1[5]), cvtpk(p1[6], p1[7])};
    pa[3] = (u32x4){cvtpk(p1[8], p1[9]), cvtpk(p1[10], p1[11]), cvtpk(p1[12], p1[13]), cvtpk(p1[14], p1[15])};
}
__host__ __device__ constexpr unsigned long long na_lane_mask2(int r, int cls) {
    unsigned long long mk = 0;
    for (int lane = 0; lane < 64; ++lane) { const int hi = lane >> 5, j = lane & 15, cr = (r & 3) + 8 * (r >> 2) + 4 * hi;
        int lo = 0;
        if (cls == 0) lo = (j - 8 < 0) ? 0 : j - 8; else if (cls == 1) lo = j; else lo = (8 + j > 16) ? 16 : 8 + j;
        if (cr >= lo && cr < lo + 16) mk |= 1ull << lane; }
    return mk;
}
__device__ __forceinline__ float rowmax16(f32x16& p0) {
    float a = max3f(p0[0], p0[1], p0[2]), b = max3f(p0[3], p0[4], p0[5]);
    a = max3f(a, p0[6], p0[7]); b = max3f(b, p0[8], p0[9]); a = max3f(a, p0[10], p0[11]); b = max3f(b, p0[12], p0[13]); a = max3f(a, p0[14], p0[15]);
    float r; asm("v_max_f32_e32 %0, %1, %2" : "=v"(r) : "v"(a), "v"(b)); return r;
}
template <int CLS>
__device__ __forceinline__ void qk_step1(const ATT_LAS unsigned char* Kblk, const i32x8q& qf, float& m, float& l, f32x16 (&o)[2], u32x4 (&pa)[2], ATT_LAS float* wsf, const ATT_LAS float* lbase, int r32, int hi) {
    f32x16 p0;
#pragma unroll
    for (int r = 0; r < 16; ++r) p0[r] = 0.f;
    const ATT_LAS unsigned char* kb = Kblk + hi * 2048 + r32 * 16;
    { const i32x8q k0 = NA_KFRAG(kb); const f32x16 z = p0; p0 = mfma_qk8(k0, qf, z); }
    asm volatile("s_nop 15\n\ts_nop 7" : "+v"(p0));
#pragma unroll
    for (int r = 0; r < 16; ++r) p0[r] = sel_mask(p0[r] + lbase[(r & 3) + 8 * (r >> 2)], na_lane_mask2(r, CLS));
    float mx = rowmax16(p0);
    mx = half_max(mx);
    const float mn = fmaxf(m, mx);
    if (__any(mx > m + RESC_THR)) {
        const float alpha = __builtin_amdgcn_exp2f(m - mn);
        l *= alpha; m = mn;
        int le_; asm volatile("v_mbcnt_lo_u32_b32 %0, -1, 0\n\tv_mbcnt_hi_u32_b32 %0, -1, %0" : "=v"(le_)); const int hi_ = le_ >> 5;
        if (le_ < 32) wsf[le_] = alpha;
        ATT_LDSW();
#pragma unroll
        for (int g = 0; g < 4; ++g) { const f32x4 a4 = *(const ATT_LAS f32x4*)(wsf + 8 * g + 4 * hi_);
#pragma unroll
            for (int db = 0; db < 2; ++db) { o[db][4 * g] *= a4[0]; o[db][4 * g + 1] *= a4[1]; o[db][4 * g + 2] *= a4[2]; o[db][4 * g + 3] *= a4[3]; } }
        ATT_LDSW();
    }
    float s = 0.f;
#pragma unroll
    for (int r = 0; r < 16; ++r) { p0[r] = __builtin_amdgcn_exp2f(p0[r] - m); s += p0[r]; }
    l += s;
    pa[0] = (u32x4){cvtpk(p0[0], p0[1]), cvtpk(p0[2], p0[3]), cvtpk(p0[4], p0[5]), cvtpk(p0[6], p0[7])};
    pa[1] = (u32x4){cvtpk(p0[8], p0[9]), cvtpk(p0[10], p0[11]), cvtpk(p0[12], p0[13]), cvtpk(p0[14], p0[15])};
}
__device__ __forceinline__ bf16x8 vfrag(const ATT_LAS unsigned char* p) { const s16x4 lo = vtr((const ATT_LAS char*)p), hi4 = vtr((const ATT_LAS char*)p + 512); return (bf16x8){lo[0], lo[1], lo[2], lo[3], hi4[0], hi4[1], hi4[2], hi4[3]}; }

#define ATT_BAR() do { asm volatile("s_waitcnt lgkmcnt(0)" ::: "memory"); __builtin_amdgcn_s_barrier(); asm volatile("" ::: "memory"); } while (0)
template <int CLS>
__device__ __forceinline__ bool na_fast1(const ATT_LAS unsigned char* kb, const i32x8q& qf, const f32x16& negm, float& l, u32x4 (&pa)[2], const ATT_LAS float* lbase) {
    float bz[16];
#pragma unroll
    for (int r = 0; r < 16; ++r) bz[r] = lbase[(r & 3) + 8 * (r >> 2)];
    f32x16 p0 = mfma_qk8(NA_KFRAG(kb), qf, negm);
    asm volatile("s_nop 15\n\ts_nop 7" : "+v"(p0), "+v"(bz[0]), "+v"(bz[1]), "+v"(bz[2]), "+v"(bz[3]), "+v"(bz[4]), "+v"(bz[5]), "+v"(bz[6]), "+v"(bz[7]), "+v"(bz[8]), "+v"(bz[9]), "+v"(bz[10]), "+v"(bz[11]), "+v"(bz[12]), "+v"(bz[13]), "+v"(bz[14]), "+v"(bz[15]));
    float t[16], a[16]; float s = 0.f;
#pragma unroll
    for (int r = 0; r < 16; ++r) t[r] = sel_mask(p0[r] + bz[r], na_lane_mask2(r, CLS));
    SM_EXPSUM8(a, t, 0, s); SM_EXPSUM8(a, t, 8, s);
    if (__any(!(s < SUM_BIG))) return false;
    l += s;
    pa[0] = (u32x4){cvtpk(a[0], a[1]), cvtpk(a[2], a[3]), cvtpk(a[4], a[5]), cvtpk(a[6], a[7])};
    pa[1] = (u32x4){cvtpk(a[8], a[9]), cvtpk(a[10], a[11]), cvtpk(a[12], a[13]), cvtpk(a[14], a[15])};
    return true;
}
__device__ __forceinline__ bool ctx_fast(const ATT_LAS unsigned char* kb, const i32x8q& qf, const f32x16& negm, float& l, u32x4 (&pa)[4]) {
    i32x8q k0 = NA_KFRAG(kb), k1 = NA_KFRAG(kb + 512);
    asm volatile("" : "+v"(k0), "+v"(k1));
    f32x16 p0 = mfma_qk8(k0, qf, negm), p1 = mfma_qk8(k1, qf, negm);
    return softmax_fast(p0, p1, l, pa);
}
#define NA_VRD(i, addr, off) asm volatile("ds_read_b64_tr_b16 %0, %2 offset:%3\n\tds_read_b64_tr_b16 %1, %2 offset:%4" : "=&v"(vl[i]), "=&v"(vh[i]) : "v"(addr), "n"(off), "n"((off) + 512) : "memory")
#define NA_VFRAG(i) ((bf16x8){vl[i][0], vl[i][1], vl[i][2], vl[i][3], vh[i][0], vh[i][1], vh[i][2], vh[i][3]})
__device__ __forceinline__ void na_unit(int b, int h, int rg, const unsigned char* Q, const unsigned char* K, const bf16_t* V, bf16_t* O, const float* rpb, ATT_LAS unsigned char* lds, int wave_in, bool ld_rpb = true) {
    ATT_IDS();
    const bool latq = rg < 8;
    int r0 = 0, cg = 0, rsA = 0, rsB = 0, kbase = 0, kr_lo = 0, n_lat = 0, qrow;
    if (latq) { r0 = 4 * rg + 2 * (wid >> 2); cg = wid & 3; rsA = r0 - 4; rsA = rsA < 0 ? 0 : (rsA > 24 ? 24 : rsA); rsB = r0 + 1 - 4; rsB = rsB < 0 ? 0 : (rsB > 24 ? 24 : rsB);
        kbase = 16 * cg - 8; kbase = kbase < 0 ? 0 : (kbase > 32 ? 32 : kbase);
        kr_lo = 4 * rg - 4; kr_lo = kr_lo < 0 ? 0 : (kr_lo > 24 ? 24 : kr_lo); int kh = 4 * rg + 3 - 4; kh = kh < 0 ? 0 : (kh > 24 ? 24 : kh); n_lat = kh + 7 - kr_lo + 1;
        qrow = b * 2048 + r0 * 64 + 16 * cg; }
    else qrow = 32768 + b * 256 + wid * 32;
    const int qoff = latq ? ((r32 >> 4) * 64 + (r32 & 15)) : r32;
    const int NT = n_lat + 4;
    ATT_LAS float* wsf = (ATT_LAS float*)(lds + L_WSF) + wid * 128;
    ATT_LAS float* rpbL = (ATT_LAS float*)(lds + L_RPB) + 64;
    __syncthreads();
    ATT_LAS float* ninfL = rpbL + 800;
    const bool ldr = latq && ld_rpb && tid < 465; float rv_ = 0.f; if (ldr) rv_ = rpb[h * 465 + tid];
    if (latq && ld_rpb && tid >= 480) ninfL[tid - 480] = -INFINITY;
    const unsigned kvo = (unsigned)(lane * PITCH + h * 64 + (wid & 3) * 16), vvo = (unsigned)(((16 * (wid & 3) + (lane >> 2)) * PITCH + h * 64 + (wid >> 2) * 32 + (lane & 3) * 8) * 2);
#define NA_TROW(t) ((t) < n_lat ? b * 2048 + (kr_lo + (t)) * 64 : 32768 + b * 256 + ((t) - n_lat) * 64)
#define NA_DMA(t, bo) do { const size_t ro_ = (size_t)NA_TROW(t) * PITCH; \
        dma16s((const char*)K + ro_, kvo, lds + L_K + (bo) + (wid & 3) * 1024); dma16s((const char*)V + ro_ * 2, vvo, lds + L_NAV + (bo) + wid * 1024); } while (0)
    NA_DMA(0, 0); NA_DMA(1, 8192); NA_DMA(2, 16384); NA_DMA(3, 24576);
    if (NT > 4) NA_DMA(4, 32768);
    i32x8q qf; { const unsigned char* qp = Q + (size_t)(qrow + qoff) * PITCH + h * 64 + hi * 32; qf = __builtin_shufflevector(*(const i32x4q*)(qp), *(const i32x4q*)(qp + 16), 0, 1, 2, 3, 4, 5, 6, 7); }
    asm volatile("" : "+v"(qf), "+v"(rv_));
    if (ldr) rpbL[(tid / 31) * 48 + tid % 31] = rv_ * LOG2E;
    float m = -1e30f, l = 0.f; f32x16 o[2], negm;
#pragma unroll
    for (int i = 0; i < 16; ++i) { o[0][i] = 0.f; o[1][i] = 0.f; negm[i] = 0.f; }
    bool first = true;
    const int vb = ((lane >> 4) & 1) * 32 + (lane & 3) * 8 + (4 * hi + ((lane & 15) >> 2)) * 64;
    const int cq = 16 * cg + (r32 & 15), rq = r0 + (r32 >> 4);
    int b0 = 0, b5 = 40960;
    for (int t = 0; t < NT; ++t) {
        { const int fl = NT - 1 - t;
          if (fl >= 4) asm volatile("s_waitcnt vmcnt(8)" ::: "memory"); else if (fl == 3) asm volatile("s_waitcnt vmcnt(6)" ::: "memory"); else if (fl == 2) asm volatile("s_waitcnt vmcnt(4)" ::: "memory");
          else if (fl == 1) asm volatile("s_waitcnt vmcnt(2)" ::: "memory"); else asm volatile("s_waitcnt vmcnt(0)" ::: "memory"); }
        ATT_BAR();
        if (t + 5 < NT) NA_DMA(t + 5, b5);
        bool mine = true; int kr = 0;
        if (t < n_lat) { kr = kr_lo + t; mine = (kr >= rsA) && (kr <= rsB + 7); }
        if (mine) {
            const ATT_LAS unsigned char* Kimg = lds + L_K + b0; const ATT_LAS unsigned char* Vimg = lds + L_NAV + b0;
            if (t < n_lat) {
                const bool rowok = (r32 >> 4) ? (kr >= rsB) : (kr <= rsA + 7);
                const ATT_LAS float* lb = rowok ? rpbL + (kr - rq + 7) * 48 + (kbase - cq + 15 + 4 * hi) : ninfL;
                s16x4 vl[4], vh[4]; { const unsigned va = (unsigned)(uintptr_t)(Vimg + vb + kbase * 64); NA_VRD(0, va, 0); NA_VRD(1, va, 4096); NA_VRD(2, va, 1024); NA_VRD(3, va, 4096 + 1024); }
                u32x4 pa[2]; bool ok = false;
                const ATT_LAS unsigned char* kbf = Kimg + kbase * 16 + hi * 2048 + r32 * 16;
                if (!first) { if (cg == 0) ok = na_fast1<0>(kbf, qf, negm, l, pa, lb); else if (cg == 3) ok = na_fast1<2>(kbf, qf, negm, l, pa, lb); else ok = na_fast1<1>(kbf, qf, negm, l, pa, lb); }
                if (__builtin_expect(!ok, 0)) {
                    if (cg == 0) qk_step1<0>(Kimg + kbase * 16, qf, m, l, o, pa, wsf, lb, r32, hi); else if (cg == 3) qk_step1<2>(Kimg + kbase * 16, qf, m, l, o, pa, wsf, lb, r32, hi); else qk_step1<1>(Kimg + kbase * 16, qf, m, l, o, pa, wsf, lb, r32, hi);
#pragma unroll
                    for (int i = 0; i < 16; ++i) negm[i] = -m;
                    first = false; }
                asm volatile("s_waitcnt lgkmcnt(0)" : "+v"(vl[0]), "+v"(vh[0]), "+v"(vl[1]), "+v"(vh[1]), "+v"(vl[2]), "+v"(vh[2]), "+v"(vl[3]), "+v"(vh[3]) :: "memory");
                o[0] = __builtin_amdgcn_mfma_f32_32x32x16_bf16(__builtin_bit_cast(bf16x8, pa[0]), NA_VFRAG(0), o[0], 0, 0, 0); o[1] = __builtin_amdgcn_mfma_f32_32x32x16_bf16(__builtin_bit_cast(bf16x8, pa[0]), NA_VFRAG(1), o[1], 0, 0, 0);
                o[0] = __builtin_amdgcn_mfma_f32_32x32x16_bf16(__builtin_bit_cast(bf16x8, pa[1]), NA_VFRAG(2), o[0], 0, 0, 0); o[1] = __builtin_amdgcn_mfma_f32_32x32x16_bf16(__builtin_bit_cast(bf16x8, pa[1]), NA_VFRAG(3), o[1], 0, 0, 0);
            } else {
                s16x4 vl[8], vh[8]; { const unsigned va = (unsigned)(uintptr_t)(Vimg + vb); NA_VRD(0, va, 0); NA_VRD(1, va, 4096); NA_VRD(2, va, 1024); NA_VRD(3, va, 4096 + 1024); NA_VRD(4, va, 2048); NA_VRD(5, va, 4096 + 2048); NA_VRD(6, va, 3072); NA_VRD(7, va, 4096 + 3072); }
                u32x4 pa[4]; bool ok = false;
                if (!first) ok = ctx_fast(Kimg + hi * 2048 + r32 * 16, qf, negm, l, pa);
                if (__builtin_expect(!ok, 0)) { NoMask mk; qk_step<2>(Kimg, qf, m, l, o, pa, wsf, mk, r32, hi);
#pragma unroll
                    for (int i = 0; i < 16; ++i) negm[i] = -m;
                    first = false; }
                asm volatile("s_waitcnt lgkmcnt(0)" : "+v"(vl[0]), "+v"(vh[0]), "+v"(vl[1]), "+v"(vh[1]), "+v"(vl[2]), "+v"(vh[2]), "+v"(vl[3]), "+v"(vh[3]), "+v"(vl[4]), "+v"(vh[4]), "+v"(vl[5]), "+v"(vh[5]), "+v"(vl[6]), "+v"(vh[6]), "+v"(vl[7]), "+v"(vh[7]) :: "memory");
#pragma unroll
                for (int ks = 0; ks < 4; ++ks) { o[0] = __builtin_amdgcn_mfma_f32_32x32x16_bf16(__builtin_bit_cast(bf16x8, pa[ks]), NA_VFRAG(2 * ks), o[0], 0, 0, 0);
                    o[1] = __builtin_amdgcn_mfma_f32_32x32x16_bf16(__builtin_bit_cast(bf16x8, pa[ks]), NA_VFRAG(2 * ks + 1), o[1], 0, 0, 0); }
            }
        }
        b0 = (b0 == 40960) ? 0 : b0 + 8192; b5 = (b5 == 40960) ? 0 : b5 + 8192;
    }
#undef NA_DMA
#undef NA_TROW
#undef NA_VRD
#undef NA_VFRAG
    l = half_sum(l);
    if (hi == 0) wsf[r32] = __builtin_amdgcn_rcpf(l);
    ATT_LDSW();
    unsigned char* Ow = (unsigned char*)O + (size_t)qrow * PITCH + h * 64;
#pragma unroll
    for (int g = 0; g < 4; ++g) { const f32x4 a4 = *(const ATT_LAS f32x4*)(wsf + 8 * g + 4 * hi);
#pragma unroll
        for (int j = 0; j < 4; ++j) { const int q = (latq ? (g >> 1) * 64 + 8 * (g & 1) : 8 * g) + 4 * hi + j;
#pragma unroll
            for (int db = 0; db < 2; ++db) Ow[(size_t)q * PITCH + db * 32 + r32] = f2f8(o[db][4 * g + j] * a4[j]); } }
    ATT_LDSW();
}

template <int NDB>
__device__ __forceinline__ void softmax_step(f32x16& p0, f32x16& p1, float& m, float& l, f32x16 (&o)[NDB], u32x4 (&pa)[4], ATT_LAS float* wsf, int r32, int hi) {
    float mx = rowmax32(p0, p1);
    mx = half_max(mx);
    const float mn = fmaxf(m, mx);
    if (__any(mx > m + RESC_THR)) {
        const float alpha = __builtin_amdgcn_exp2f(m - mn);
        l *= alpha; m = mn;
        int le_; asm volatile("v_mbcnt_lo_u32_b32 %0, -1, 0\n\tv_mbcnt_hi_u32_b32 %0, -1, %0" : "=v"(le_)); const int hi_ = le_ >> 5;
        if (le_ < 32) wsf[le_] = alpha;
        ATT_LDSW();
#pragma unroll
        for (int g = 0; g < 4; ++g) { const f32x4 a4 = *(const ATT_LAS f32x4*)(wsf + 8 * g + 4 * hi_);
#pragma unroll
            for (int db = 0; db < NDB; ++db) { o[db][4 * g] *= a4[0]; o[db][4 * g + 1] *= a4[1]; o[db][4 * g + 2] *= a4[2]; o[db][4 * g + 3] *= a4[3]; } }
        ATT_LDSW();
    }
    float s = 0.f;
#pragma unroll
    for (int r = 0; r < 16; ++r) { p0[r] = __builtin_amdgcn_exp2f(p0[r] - m); p1[r] = __builtin_amdgcn_exp2f(p1[r] - m); s += p0[r] + p1[r]; }
    l += s;
    pa[0] = (u32x4){cvtpk(p0[0], p0[1]), cvtpk(p0[2], p0[3]), cvtpk(p0[4], p0[5]), cvtpk(p0[6], p0[7])};
    pa[1] = (u32x4){cvtpk(p0[8], p0[9]), cvtpk(p0[10], p0[11]), cvtpk(p0[12], p0[13]), cvtpk(p0[14], p0[15])};
    pa[2] = (u32x4){cvtpk(p1[0], p1[1]), cvtpk(p1[2], p1[3]), cvtpk(p1[4], p1[5]), cvtpk(p1[6], p1[7])};
    pa[3] = (u32x4){cvtpk(p1[8], p1[9]), cvtpk(p1[10], p1[11]), cvtpk(p1[12], p1[13]), cvtpk(p1[14], p1[15])};
}
__device__ __forceinline__ int pk2f8(float a, float b, int old, bool hiw) { return hiw ? __builtin_amdgcn_cvt_pk_fp8_f32(a, b, old, true) : __builtin_amdgcn_cvt_pk_fp8_f32(a, b, old, false); }
#define SM_PACK8(A, B) ((i32x8q){pk2f8(A[2], A[3], pk2f8(A[0], A[1], 0, false), true), pk2f8(A[6], A[7], pk2f8(A[4], A[5], 0, false), true), pk2f8(A[10], A[11], pk2f8(A[8], A[9], 0, false), true), pk2f8(A[14], A[15], pk2f8(A[12], A[13], 0, false), true), \
                               pk2f8(B[2], B[3], pk2f8(B[0], B[1], 0, false), true), pk2f8(B[6], B[7], pk2f8(B[4], B[5], 0, false), true), pk2f8(B[10], B[11], pk2f8(B[8], B[9], 0, false), true), pk2f8(B[14], B[15], pk2f8(B[12], B[13], 0, false), true)})
constexpr float SUM_BIG8 = 256.0f;
#define SM_PK4(E, I) pk2f8(E[(I) + 2], E[(I) + 3], pk2f8(E[(I)], E[(I) + 1], 0, false), true)
__device__ __forceinline__ bool softmax_fast8(f32x16& p0, f32x16& p1, float& l, i32x8q& pq) {
    asm volatile("s_nop 15\n\ts_nop 7" : "+v"(p0), "+v"(p1));
    float s = 0.f;
    { float e[16]; SM_EXPSUM8(e, p0, 0, s); pq[0] = SM_PK4(e, 0); pq[1] = SM_PK4(e, 4); }
    { float e[16]; SM_EXPSUM8(e, p0, 8, s); pq[2] = SM_PK4(e, 8); pq[3] = SM_PK4(e, 12); }
    { float e[16]; SM_EXPSUM8(e, p1, 0, s); pq[4] = SM_PK4(e, 0); pq[5] = SM_PK4(e, 4); }
    { float e[16]; SM_EXPSUM8(e, p1, 8, s); pq[6] = SM_PK4(e, 8); pq[7] = SM_PK4(e, 12); }
    if (__any(!(s < SUM_BIG8))) return false;
    l += s;
    return true;
}
__device__ __forceinline__ void softmax_step8(f32x16& p0, f32x16& p1, float& m, float& l, f32x16 (&o)[4], i32x8q& pq) {
    float mx = rowmax32(p0, p1);
    mx = half_max(mx);
    const float mn = fmaxf(m, mx);
    if (__any(mx > m + RESC_THR)) {
        const float alpha = __builtin_amdgcn_exp2f(m - mn);
        l *= alpha; m = mn;
#pragma unroll
        for (int db = 0; db < 4; ++db)
#pragma unroll
            for (int i = 0; i < 16; ++i) o[db][i] *= alpha;
    }
    float s = 0.f;
#pragma unroll
    for (int r = 0; r < 16; ++r) { p0[r] = __builtin_amdgcn_exp2f(p0[r] - m); p1[r] = __builtin_amdgcn_exp2f(p1[r] - m); s += p0[r] + p1[r]; }
    l += s;
    pq = SM_PACK8(p0, p1);
}
#define ATT_VMW() asm volatile("s_waitcnt vmcnt(0)" ::: "memory")
template <int XM = 0>
__device__ __forceinline__ void diff_unit(int b, int hd, int qb, const unsigned char* Q, const unsigned char* K, const unsigned char* V, bf16_t* O, float lam, float outscale, const float* subln, ATT_LAS unsigned char* lds, int wave_in) {
    ATT_IDS();
    int grp; asm volatile("s_lshr_b32 %0, %1, 2" : "=s"(grp) : "s"(wid) : "scc");
    constexpr bool X_DMA = (XM != 2 && XM < 6), X_SM = (XM == 0 || XM == 2 || XM == 4 || XM == 5 || XM == 6 || XM == 10), X_QK2 = (XM == 0 || XM == 2 || XM == 3 || XM == 4 || XM == 6 || XM == 11),
                   X_PV = (XM == 0 || XM == 2 || XM == 3 || XM == 5 || XM == 7 || XM == 8), X_QK1 = (XM == 0 || XM == 2 || XM == 3 || XM == 4 || XM == 7 || XM == 9);
    const int qrow = b * 2048 + qb * 256 + wid * 32;
    constexpr int NT = 36;
    ATT_LAS float* wsf = (ATT_LAS float*)(lds + L_WSF) + wid * 128;
    __syncthreads();
#define DF_OFFS() int ld_; asm volatile("v_mbcnt_lo_u32_b32 %0, -1, 0\n\tv_mbcnt_hi_u32_b32 %0, -1, %0" : "=v"(ld_)); \
        const unsigned kvo = (unsigned)((16 * (wid & 3) + (ld_ >> 2)) * PITCH + hd * 128 + 64 * ((wid >> 2) & 1) + 16 * ((ld_ & 3) ^ ((ld_ >> 4) & 3))), \
                       vvo = (unsigned)((16 * wid + (ld_ >> 2)) * 2304 + 16 * ((ld_ & 3) ^ ((ld_ >> 4) & 3))); (void)kvo; (void)vvo
#define DF_TROW(t) ((t) < 32 ? b * 2048 + (t) * 64 : 32768 + b * 256 + ((t) - 32) * 64)
#define DF_DMA_K(t, kbo) do { DF_OFFS(); const char* kb_ = (const char*)K + (size_t)DF_TROW(t) * PITCH;     \
        dma16s(kb_, kvo, lds + L_K + (kbo) + wid * 1024); } while (0)
#define DF_DMA_V(t) do { DF_OFFS(); const char* vb_ = (const char*)V + (size_t)((b * 8 + hd) * 128) * 2304 + (t) * 64; const int bo_ = ((t) & 3);     \
        dma16s(vb_, vvo, lds + L_V + bo_ * 8192 + wid * 1024); } while (0)
    DF_DMA_K(0, 0); DF_DMA_K(1, KBUF); DF_DMA_V(0); DF_DMA_V(1);
    ATT_LAS unsigned char* qst = lds + L_QST + wid * 8192;
#pragma unroll
    for (int d0 = 0; d0 < 4; ++d0) *(ATT_LAS u32x4*)(qst + d0 * 1024 + lane * 16) = *(const u32x4*)(Q + (size_t)(qrow + r32) * PITCH + hd * 128 + (d0 >> 1) * 64 + hi * 32 + (d0 & 1) * 16);
    float m1 = -1e30f, l1 = 0.f, m2 = -1e30f, l2 = 0.f; f32x16 o1[4], o2[4];
#pragma unroll
    for (int db = 0; db < 4; ++db)
#pragma unroll
        for (int i = 0; i < 16; ++i) { o1[db][i] = 0.f; o2[db][i] = 0.f; }
    const int vb = ((lane >> 4) & 1) * 32 + (lane & 3) * 8 + (4 * hi + ((lane & 15) >> 2)) * 64;
    const int kfe = r32 * 64 + (((2 * hi) ^ ((r32 >> 2) & 3)) * 16);
    f32x16 sa, sb, sc2, sd2;
    i32x8q pq1, pq2;
#define DF_QK(kbo, SUB, NM, SA_, SB_) do { const float nm_ = (NM); int kfo_ = kfe; asm volatile("v_xor_b32 %0, 16, %0" : "+v"(kfo_));     \
        const ATT_LAS unsigned char* kbe_ = lds + L_K + (kbo) + (SUB) * 4096 + kfe; const ATT_LAS unsigned char* kbo_ = lds + L_K + (kbo) + (SUB) * 4096 + kfo_; \
        f32x16 cin_; _Pragma("unroll") for (int r_ = 0; r_ < 16; ++r_) cin_[r_] = nm_; \
        i32x4q ql_ = *(const ATT_LAS i32x4q*)(qst + ((SUB) * 2) * 1024 + lane * 16), qh_ = *(const ATT_LAS i32x4q*)(qst + ((SUB) * 2 + 1) * 1024 + lane * 16); \
        i32x4q k0l_ = *(const ATT_LAS i32x4q*)(kbe_), k0h_ = *(const ATT_LAS i32x4q*)(kbo_), k1l_ = *(const ATT_LAS i32x4q*)(kbe_ + 2048), k1h_ = *(const ATT_LAS i32x4q*)(kbo_ + 2048); \
        asm volatile("" : "+v"(ql_), "+v"(qh_), "+v"(k0l_), "+v"(k0h_), "+v"(k1l_), "+v"(k1h_));     \
        const i32x8q q8_ = __builtin_shufflevector(ql_, qh_, 0, 1, 2, 3, 4, 5, 6, 7), k08_ = __builtin_shufflevector(k0l_, k0h_, 0, 1, 2, 3, 4, 5, 6, 7), k18_ = __builtin_shufflevector(k1l_, k1h_, 0, 1, 2, 3, 4, 5, 6, 7); \
        SA_ = __builtin_amdgcn_mfma_scale_f32_32x32x64_f8f6f4(k08_, q8_, cin_, 0, 0, 0, 0x7f7f7f7f, 0, 0x7c7c7c7c);     \
        SB_ = __builtin_amdgcn_mfma_scale_f32_32x32x64_f8f6f4(k18_, q8_, cin_, 0, 0, 0, 0x7f7f7f7f, 0, 0x7c7c7c7c); } while (0)
    ATT_VMW(); ATT_BAR();
    if (grp == 1) ATT_BAR();
    int kcur = 0, knxt = KBUF, kfree = 2 * KBUF;
#define DF_VLD() do { _Pragma("unroll") for (int mb = 0; mb < 2; ++mb) { vl_[mb] = *(const ATT_LAS i32x4q*)(Vimg + mb * 2048 + kfe); vh_[mb] = *(const ATT_LAS i32x4q*)(Vimg + mb * 2048 + vfo_); } } while (0)
#define DF_SEG(SUB, M_, L_, O_) do { \
        const ATT_LAS unsigned char* Vimg = lds + L_V + (t & 3) * 8192; int vfo_ = kfe; asm volatile("v_xor_b32 %0, 16, %0" : "+v"(vfo_)); \
        i32x4q vl_[4], vh_[4]; \
        DF_QK(kcur, SUB, (t == 0) ? 0.f : -(M_), sa, sb);     \
        DF_VLD();     \
        if (t == 0 || !softmax_fast8(sa, sb, L_, pq1)) { if (t != 0) DF_QK(kcur, SUB, 0.f, sa, sb); softmax_step8(sa, sb, M_, L_, O_, pq1); DF_VLD();     } \
        _Pragma("unroll") for (int mb = 2; mb < 4; ++mb) { vl_[mb] = *(const ATT_LAS i32x4q*)(Vimg + mb * 2048 + kfe); vh_[mb] = *(const ATT_LAS i32x4q*)(Vimg + mb * 2048 + vfo_); } \
        asm volatile("" : "+v"(vl_[0]), "+v"(vh_[0]), "+v"(vl_[1]), "+v"(vh_[1])); \
        _Pragma("unroll") for (int mb = 0; mb < 2; ++mb) { const i32x8q vf_ = __builtin_shufflevector(vl_[mb], vh_[mb], 0, 1, 2, 3, 4, 5, 6, 7); \
            O_[mb] = __builtin_amdgcn_mfma_scale_f32_32x32x64_f8f6f4(vf_, pq1, O_[mb], 0, 0, 0, 0x7f7f7f7f, 0, 0x7f7f7f7f); } \
        asm volatile("" : "+v"(vl_[2]), "+v"(vh_[2]), "+v"(vl_[3]), "+v"(vh_[3])); \
        _Pragma("unroll") for (int mb = 2; mb < 4; ++mb) { const i32x8q vf_ = __builtin_shufflevector(vl_[mb], vh_[mb], 0, 1, 2, 3, 4, 5, 6, 7); \
            O_[mb] = __builtin_amdgcn_mfma_scale_f32_32x32x64_f8f6f4(vf_, pq1, O_[mb], 0, 0, 0, 0x7f7f7f7f, 0, 0x7f7f7f7f); } } while (0)
#pragma unroll 1
    for (int t = 0; t < NT; ++t) {
        if (X_DMA && grp == 1) { if (t + 2 < NT) { DF_DMA_K(t + 2, kfree); DF_DMA_V(t + 2); } }
        DF_SEG(0, m1, l1, o1);
        __builtin_amdgcn_sched_barrier(0);
        if (X_DMA && grp == 0) ATT_VMW();
        ATT_BAR();
        if (X_DMA && grp == 0) { if (t + 2 < NT) { DF_DMA_K(t + 2, kfree); DF_DMA_V(t + 2); } }
        DF_SEG(1, m2, l2, o2);
        __builtin_amdgcn_sched_barrier(0);
        if (X_DMA && grp == 1) ATT_VMW();
        ATT_BAR();
        { const int k_ = kcur; kcur = knxt; knxt = kfree; kfree = k_; }
    }
#undef DF_SEG
#undef DF_VLD
    if (grp == 0) ATT_BAR();
#undef DF_QK
#undef DF_DMA_K
#undef DF_OFFS
#undef DF_DMA_V
#undef DF_TROW
    l1 = half_sum(l1); l2 = half_sum(l2);
    { const float i1 = __builtin_amdgcn_rcpf(l1), i2 = wsf[120] * __builtin_amdgcn_rcpf(l2);
      float ss = 0.f;
#pragma unroll
      for (int mb = 0; mb < 4; ++mb)
#pragma unroll
          for (int r = 0; r < 16; ++r) { const float v = o1[mb][r] * i1 - o2[mb][r] * i2; o1[mb][r] = v; ss += v * v; }
      ss = half_sum(ss);
      const float rn = __builtin_amdgcn_rsqf(ss * (1.0f / 128.0f) + 1e-6f) * outscale;
      int lane_e; asm volatile("v_mbcnt_lo_u32_b32 %0, -1, 0\n\tv_mbcnt_hi_u32_b32 %0, -1, %0" : "=v"(lane_e)); const int r32e = lane_e & 31, hie = lane_e >> 5;
      unsigned char* Ow = (unsigned char*)O + (size_t)(qrow + r32e) * PITCH + hd * 128 + 4 * hie;
#pragma unroll
      for (int mb = 0; mb < 4; ++mb)
#pragma unroll
          for (int a = 0; a < 4; ++a) { const f32x4 g4 = *(const f32x4*)(subln + 32 * mb + 8 * a + 4 * hie);
              *(unsigned*)(Ow + 32 * mb + 8 * a) = pg8::pk4_fp8(o1[mb][4 * a] * rn * g4[0], o1[mb][4 * a + 1] * rn * g4[1], o1[mb][4 * a + 2] * rn * g4[2], o1[mb][4 * a + 3] * rn * g4[3]); } }
    ATT_LDSW();
}
}

#define GAS __attribute__((address_space(1)))
#define LAS __attribute__((address_space(3)))
typedef unsigned short bf16;
typedef unsigned v4u __attribute__((ext_vector_type(4)));
typedef float f32x4 __attribute__((ext_vector_type(4)));
typedef short bf16x8 __attribute__((ext_vector_type(8)));
typedef GAS unsigned gu32;
typedef GAS unsigned long long gu64;
#define RLX_AGENT __ATOMIC_RELAXED, __HIP_MEMORY_SCOPE_AGENT
#define LDS_WAIT() asm volatile("s_waitcnt lgkmcnt(0)" ::: "memory")
#define VM_WAIT() asm volatile("s_waitcnt vmcnt(0)" ::: "memory")
__device__ __forceinline__ unsigned long long rt() { return __builtin_amdgcn_s_memrealtime(); }
__device__ __forceinline__ unsigned f2bf(float f) { unsigned u = __builtin_bit_cast(unsigned, f); return (u + 0x7fffu + ((u >> 16) & 1u)) >> 16; }
__device__ __forceinline__ unsigned pk2(float lo, float hi) { return f2bf(lo) | (f2bf(hi) << 16); }

#define XB_TMO      128
#define XB_XCNT(j)  (256  + 64 * (j))
#define XB_XSUB(j)  (1280 + 64 * (j))
#define XB_XGEN(j)  (2304 + 64 * (j))
#define XB_TOP      3328
#define XB_TOPGEN   3392
#define XCD_BAR_WORDS 3456
#define XB_SPIN_CAP (1u << 18)

__device__ __forceinline__ unsigned xb_ld(unsigned* p)              { return __hip_atomic_load(p, __ATOMIC_RELAXED, __HIP_MEMORY_SCOPE_AGENT); }
__device__ __forceinline__ unsigned xb_add(unsigned* p, unsigned v) { return __hip_atomic_fetch_add(p, v, __ATOMIC_RELAXED, __HIP_MEMORY_SCOPE_AGENT); }
__device__ __forceinline__ unsigned xb_xcc_id() { return (unsigned)__builtin_amdgcn_s_getreg((3 << 11) | 20) & 0xFu; }
#define XB_SPIN(cond, bar) do { unsigned _sp = 0; while (cond) { __builtin_amdgcn_s_sleep(1); \
    if ((++_sp & 255u) == 0u) { if (xb_ld(&(bar)[XB_TMO])) break; if (_sp > XB_SPIN_CAP) { atomicAdd(&(bar)[XB_TMO], 1u); break; } } } } while (0)

struct XcdBarrier {
    unsigned* bar; unsigned x;
    volatile LAS unsigned* st;
};

__device__ __forceinline__ XcdBarrier xcd_barrier_post(unsigned* bar, volatile LAS unsigned* st) {
    XcdBarrier b; b.bar = bar; b.x = xb_xcc_id(); b.st = st;
    if (threadIdx.x == 0) (void)xb_add(&bar[XB_XCNT(b.x)], 1u);
    return b;
}
__device__ __forceinline__ void xcd_barrier_complete(unsigned* bar, unsigned x, unsigned& nloc, unsigned& nx) {
    const unsigned G = gridDim.x * gridDim.y * gridDim.z;
    unsigned sum, cnt, mine, sp = 0u;
    for (;;) {
        sum = 0u; cnt = 0u; mine = 0u;
#pragma unroll
        for (unsigned j = 0; j < 16; ++j) { const unsigned c = xb_ld(&bar[XB_XCNT(j)]); sum += c; cnt += (c > 0u) ? 1u : 0u; mine = (j == x) ? c : mine; }
        if (sum == G) break;
        __builtin_amdgcn_s_sleep(1);
        if ((++sp & 255u) == 0u) { if (xb_ld(&bar[XB_TMO])) break; if (sp > XB_SPIN_CAP) { atomicAdd(&bar[XB_TMO], 1u); break; } }
    }
    nloc = mine > 0u ? mine : 1u; nx = cnt > 0u ? cnt : 1u;
}

__device__ __forceinline__ void xcd_barrier(const XcdBarrier& b) {
    asm volatile("s_waitcnt vmcnt(0)" ::: "memory");
    __syncthreads();
    if (threadIdx.x == 0) {
        unsigned* bar = b.bar;
        __builtin_amdgcn_s_waitcnt(0);
        unsigned nloc = b.st[0], nx = b.st[1];
        if (nloc == 0u) { xcd_barrier_complete(bar, b.x, nloc, nx); b.st[0] = nloc; b.st[1] = nx; }
        const unsigned old = xb_add(&bar[XB_XSUB(b.x)], 1u);
        const unsigned gen = old / nloc;
        if (old + 1u == (gen + 1u) * nloc) {
            __builtin_amdgcn_fence(__ATOMIC_RELEASE, "agent");
            asm volatile("s_waitcnt vmcnt(0)" ::: "memory");
            const unsigned og = xb_add(&bar[XB_TOP], 1u);
            const unsigned tg = og / nx;
            if (og + 1u == (tg + 1u) * nx) xb_add(&bar[XB_TOPGEN], 1u);
            else XB_SPIN(xb_ld(&bar[XB_TOPGEN]) == tg, bar);
            __builtin_amdgcn_fence(__ATOMIC_ACQUIRE, "agent");
            xb_add(&bar[XB_XGEN(b.x)], 1u);
            asm volatile("s_waitcnt vmcnt(0)" ::: "memory");
        } else {
            XB_SPIN(xb_ld(&bar[XB_XGEN(b.x)]) == gen, bar);
            __builtin_amdgcn_fence(__ATOMIC_ACQUIRE, "agent");
            asm volatile("s_waitcnt vmcnt(0)" ::: "memory");
        }
    }
    __syncthreads();
}
namespace cfg {
constexpr int D = 1024, NB = 16, SEQ = 2048, CTXL = 256;
constexpr int ML = NB * SEQ, MC = NB * CTXL, MT = ML + MC;
constexpr int DFF = 2816, NE = 8, DFE = 3584, MODW = 6 * D;
constexpr int MOE_TILES_MAX = 264;
constexpr float EPS = 1e-6f, LOG2E = 1.4426950408889634f;
constexpr float LAM_INIT = 0.35550906759096925f;
}
using namespace cfg;
constexpr int NWAVES = 8;
#ifndef PROBE_PHASE
#define PROBE_PHASE -1
#endif
#ifndef PROBE_N
#define PROBE_N 2
#endif
#define REPS(k) ((PROBE_PHASE == (k)) ? PROBE_N : 1)
constexpr size_t MiB = 1u << 20;
constexpr size_t WS_CTL = 0, CTL_ZERO_BYTES = 1 * MiB;
constexpr size_t WS_MOD = 1 * MiB;
constexpr size_t WS_ROPE = 2 * MiB;
constexpr size_t WS_TOKE = 3 * MiB, WS_TOKW = WS_TOKE + 256 * 1024, WS_TOKP = WS_TOKW + 256 * 1024, WS_TOKS = WS_TOKP + 256 * 1024;
constexpr size_t WS_SSQ = 4 * MiB, WS_C6 = 6 * MiB + 512 * 1024, WS_C9 = 7 * MiB;
constexpr size_t WS_W0QKV = 8 * MiB, WS_W0O = 14 * MiB, WS_W0GU = 16 * MiB, WS_W0D = 27 * MiB, WS_W1QKV = 33 * MiB, WS_W1O = 39 * MiB;
constexpr size_t WS_WMGU = 42 * MiB, WS_WMD = 98 * MiB;
constexpr float WSCALE = 64.0f;
constexpr size_t WS_R = 128 * MiB;
constexpr size_t WS_H = WS_R, WS_Q = WS_R + 72 * MiB, WS_K = WS_R + 144 * MiB, WS_V = WS_R + 216 * MiB, WS_XCTX = WS_R + 288 * MiB;
constexpr size_t WS_ACT0 = WS_Q;
constexpr size_t WS_Y = WS_R, WS_APERM = WS_R, WS_H2 = WS_R + 132 * MiB, WS_ACT1 = WS_R + 164 * MiB, WS_END = WS_ACT1 + 231 * MiB;
constexpr size_t WS_PART = WS_END, WS_W0GU8 = WS_PART + (size_t)36 * 7 * 256 * 256 * 4, WS_END2 = WS_W0GU8 + (size_t)2 * DFF * D;
static_assert(WS_END2 <= 593 * MiB, "d_ws map");
static_assert(WS_WMD + (size_t)NE * D * DFE <= WS_R && WS_ACT0 + (size_t)MT * DFF * 2 <= WS_XCTX && WS_XCTX + (size_t)MC * D * 4 <= WS_END && WS_H2 >= WS_Y + (size_t)MOE_TILES_MAX * 256 * D * 2 && WS_ACT1 >= WS_H2 + (size_t)ML * D && WS_END <= 593 * MiB, "d_ws map");
constexpr int CW_CNT = 1024;
constexpr int CW_BAR = 4096;
constexpr int RING_OFF = 0, RING_BYTES = 155648;
constexpr int LDSCTL_OFF = RING_BYTES, MISC_OFF = LDSCTL_OFF + 320;
constexpr int TILE_E_OFF = MISC_OFF + 128;
constexpr int EBASE_OFF = TILE_E_OFF + 272 * 4;
constexpr int LDS_BYTES = 157696;
static_assert(EBASE_OFF + 128 <= LDS_BYTES, "LDS map");

__device__ __forceinline__ float wave_sum(float v) {
    v += xl::swz_xor<1>(v); v += xl::swz_xor<2>(v); v += xl::swz_xor<4>(v); v += xl::swz_xor<8>(v); v += xl::swz_xor<16>(v);
    return xl::half_sum(v);
}
__device__ __forceinline__ void transpose_item(const float* W, int K, int N, bf16* WT, int k0, int n0, int drow0, LAS float* scr, int lane) {
#pragma unroll 8
    for (int i = 0; i < 32; ++i) { const int kk = 2 * i + (lane >> 5); scr[kk * 33 + (lane & 31)] = W[(size_t)(k0 + kk) * N + n0 + (lane & 31)]; }
    LDS_WAIT(); asm volatile("" ::: "memory");
    const int c = lane & 7;
#pragma unroll
    for (int j = 0; j < 4; ++j) { const int n = (lane >> 3) + 8 * j; const LAS float* s = scr + (8 * c) * 33 + n;
        v4u o; o.x = pk2(s[0 * 33], s[1 * 33]); o.y = pk2(s[2 * 33], s[3 * 33]); o.z = pk2(s[4 * 33], s[5 * 33]); o.w = pk2(s[6 * 33], s[7 * 33]);
        *(GAS v4u*)(WT + (size_t)(drow0 + n) * K + k0 + 8 * c) = o; }
    LDS_WAIT(); asm volatile("" ::: "memory");
}
__device__ __forceinline__ void transpose_item8(const float* W, int K, int N, unsigned char* WT, int k0, int n0, int drow0, float scale, LAS float* scr, int lane) {
#pragma unroll 8
    for (int i = 0; i < 32; ++i) { const int kk = 2 * i + (lane >> 5); scr[kk * 33 + (lane & 31)] = W[(size_t)(k0 + kk) * N + n0 + (lane & 31)] * scale; }
    LDS_WAIT(); asm volatile("" ::: "memory");
    const int c = lane & 7;
#pragma unroll
    for (int j = 0; j < 4; ++j) { const int n = (lane >> 3) + 8 * j; const LAS float* s = scr + (8 * c) * 33 + n;
        unsigned long long o = (unsigned long long)pg8::pk4_fp8(s[0 * 33], s[1 * 33], s[2 * 33], s[3 * 33]) | ((unsigned long long)pg8::pk4_fp8(s[4 * 33], s[5 * 33], s[6 * 33], s[7 * 33]) << 32);
        *(GAS unsigned long long*)(WT + (size_t)(drow0 + n) * K + k0 + 8 * c) = o; }
    LDS_WAIT(); asm volatile("" ::: "memory");
}
struct CvtMat { const float* src; void* dst; int K, N, mode, nmat; float fp8scale; };
__device__ __forceinline__ void cvt_run(const CvtMat& cm, int it, LAS float* scr, int lane) {
    const int nblk = cm.N / 32, per = (cm.K / 64) * nblk;
    const int e = it / per, r = it % per, kb = r / nblk, nb = r % nblk, n0 = nb * 32;
    const int drow0 = (cm.mode == 0) ? n0 : ((n0 >> 7) * 256 + (n0 & 127) + (cm.mode == 2 ? 128 : 0));
    const int rows_per = (cm.mode == 0) ? cm.N : 2 * cm.N;
    if (cm.fp8scale != 0.f) transpose_item8(cm.src + (size_t)e * cm.K * cm.N, cm.K, cm.N, (unsigned char*)cm.dst + (size_t)e * rows_per * cm.K, kb * 64, n0, drow0, cm.fp8scale, scr, lane);
    else transpose_item(cm.src + (size_t)e * cm.K * cm.N, cm.K, cm.N, (bf16*)cm.dst + (size_t)e * rows_per * cm.K, kb * 64, n0, drow0, scr, lane);
}
__device__ __forceinline__ void moe_cvt_range(int lo, int hi, int widx, int nw, const float* wg, const float* wu, const float* wd, unsigned char* gu8, unsigned char* d8, float scale, LAS float* scr, int lane) {
    constexpr int PER = (D / 64) * (DFE / 32) * NE;
    for (int I = lo + widx; I < hi; I += nw) { const int mi = I / PER, it = I - mi * PER;
        if (mi == 0) { const CvtMat cm{wg, gu8, D, DFE, 1, NE, scale}; cvt_run(cm, it, scr, lane); }
        else if (mi == 1) { const CvtMat cm{wu, gu8, D, DFE, 2, NE, scale}; cvt_run(cm, it, scr, lane); }
        else { const CvtMat cm{wd, d8, DFE, D, 0, NE, scale}; cvt_run(cm, it, scr, lane); } }
}
constexpr int MOE_ITEMS = 3 * (D / 64) * (DFE / 32) * NE;
constexpr int MC0 = 0, MC1 = 0, MC2 = MC1 + MOE_ITEMS * 25 / 100, MC3 = MC2 + MOE_ITEMS * 12 / 100, MC4 = MOE_ITEMS, MC5 = MC4;
template <bool F8 = false, bool PRE = false>
__device__ __forceinline__ void norm_mod_row(const float* xrow, const float* gain, const float* shift, const float* scale, void* orow, int lane, f32x4 (&v)[4]) {
    const GAS f32x4* xr = (const GAS f32x4*)xrow + lane; float s2 = 0.f;
#pragma unroll
    for (int j = 0; j < 4; ++j) { if constexpr (!PRE) v[j] = xr[64 * j]; s2 += (v[j].x * v[j].x + v[j].y * v[j].y) + (v[j].z * v[j].z + v[j].w * v[j].w); }
    const float rstd = 1.0f / sqrtf(wave_sum(s2) * (1.f / D) + EPS);
    GAS unsigned long long* o8 = (GAS unsigned long long*)orow + lane;
#pragma unroll
    for (int j = 0; j < 4; ++j) { const f32x4 g = ((const f32x4*)gain)[lane + 64 * j], sh = ((const f32x4*)shift)[lane + 64 * j], sc = ((const f32x4*)scale)[lane + 64 * j];
        v[j] = (v[j] * rstd * g) * (sc + 1.0f) + sh;
        if constexpr (F8) ((GAS unsigned*)orow)[lane + 64 * j] = pg8::pk4_fp8(v[j].x, v[j].y, v[j].z, v[j].w);
        else o8[64 * j] = (unsigned long long)pk2(v[j].x, v[j].y) | ((unsigned long long)pk2(v[j].z, v[j].w) << 32); }
}

template <bool F8 = false>
__device__ __forceinline__ void norm_mod_row2(const float* xa, const float* xb, const float* gain, const float* sha, const float* sca, const float* shb, const float* scb, void* oa, void* ob, int lane) {
    const GAS f32x4* pa = (const GAS f32x4*)xa + lane; const GAS f32x4* pb = (const GAS f32x4*)xb + lane; f32x4 va[4], vb[4]; float sa = 0.f, sb = 0.f;
#pragma unroll
    for (int j = 0; j < 4; ++j) { va[j] = pa[64 * j]; vb[j] = pb[64 * j]; }
#pragma unroll
    for (int j = 0; j < 4; ++j) { sa += (va[j].x * va[j].x + va[j].y * va[j].y) + (va[j].z * va[j].z + va[j].w * va[j].w); sb += (vb[j].x * vb[j].x + vb[j].y * vb[j].y) + (vb[j].z * vb[j].z + vb[j].w * vb[j].w); }
    sa += xl::swz_xor<1>(sa); sb += xl::swz_xor<1>(sb); sa += xl::swz_xor<2>(sa); sb += xl::swz_xor<2>(sb); sa += xl::swz_xor<4>(sa); sb += xl::swz_xor<4>(sb);
    sa += xl::swz_xor<8>(sa); sb += xl::swz_xor<8>(sb); sa += xl::swz_xor<16>(sa); sb += xl::swz_xor<16>(sb); sa = xl::half_sum(sa); sb = xl::half_sum(sb);
    const float ra = 1.0f / sqrtf(sa * (1.f / D) + EPS), rb = 1.0f / sqrtf(sb * (1.f / D) + EPS);
    GAS unsigned long long* qa = (GAS unsigned long long*)oa + lane; GAS unsigned long long* qb = (GAS unsigned long long*)ob + lane;
#pragma unroll
    for (int j = 0; j < 4; ++j) { const f32x4 g = ((const f32x4*)gain)[lane + 64 * j];
        const f32x4 ha = (va[j] * ra * g) * (((const f32x4*)sca)[lane + 64 * j] + 1.0f) + ((const f32x4*)sha)[lane + 64 * j];
        const f32x4 hb = (vb[j] * rb * g) * (((const f32x4*)scb)[lane + 64 * j] + 1.0f) + ((const f32x4*)shb)[lane + 64 * j];
        if constexpr (F8) { ((GAS unsigned*)oa)[lane + 64 * j] = pg8::pk4_fp8(ha.x, ha.y, ha.z, ha.w); ((GAS unsigned*)ob)[lane + 64 * j] = pg8::pk4_fp8(hb.x, hb.y, hb.z, hb.w); }
        else { qa[64 * j] = (unsigned long long)pk2(ha.x, ha.y) | ((unsigned long long)pk2(ha.z, ha.w) << 32);
        qb[64 * j] = (unsigned long long)pk2(hb.x, hb.y) | ((unsigned long long)pk2(hb.z, hb.w) << 32); } }
}

__device__ __forceinline__ void shift_dot_rows(const bf16* Wt, int N, float* c, const LAS float* shL, int gw, int ngw, int lane) {
    for (int n = gw; n < N; n += ngw) { const GAS unsigned long long* wp = (const GAS unsigned long long*)(Wt + (size_t)n * D) + lane; f32x4 w[4];
#pragma unroll
        for (int j = 0; j < 4; ++j) { const unsigned long long a = wp[64 * j]; w[j].x = __uint_as_float((unsigned)a << 16); w[j].y = __uint_as_float((unsigned)a & 0xffff0000u); w[j].z = __uint_as_float((unsigned)(a >> 32) << 16); w[j].w = __uint_as_float((unsigned)(a >> 32) & 0xffff0000u); }
#pragma unroll 1
        for (int b = 0; b < 17; ++b) { float s = 0.f;
#pragma unroll
            for (int j = 0; j < 4; ++j) { const f32x4 h = *(const LAS f32x4*)(shL + b * 1024 + 4 * lane + 256 * j); s += (h.x * w[j].x + h.y * w[j].y) + (h.z * w[j].z + h.w * w[j].w); }
            s = wave_sum(s); if (lane == 0) c[(size_t)b * N + n] = s; } }
}

typedef float f32x16_t __attribute__((ext_vector_type(16)));
constexpr int SD_PITCH = 2064, SD_PART = 32 * SD_PITCH;
__device__ __forceinline__ void shift_img(const float* shift_rows  , LAS unsigned char* lds, int tid) {
    __syncthreads();
    const int k = tid * 2;
    typedef float f32x2_t __attribute__((ext_vector_type(2)));
    f32x2_t v[17];
#pragma unroll
    for (int r = 0; r < 17; ++r) v[r] = *(const f32x2_t*)(shift_rows + (size_t)r * MODW + k);
#pragma unroll
    for (int r = 0; r < 32; ++r) *(LAS unsigned*)(lds + r * SD_PITCH + k * 2) = (r < 17) ? pk2(v[r < 17 ? r : 0].x, v[r < 17 ? r : 0].y) : 0u;
    __syncthreads();
}
__device__ __forceinline__ void shift_dots(const float* mod, const bf16* W6, float* c6, const bf16* W9, float* c9, int idx, int nidle, LAS unsigned char* lds, int wave, int tid) {
    constexpr int NB6 = 2 * DFF / 32, NB9 = 3 * D / 32, N6 = 2 * DFF, N9 = 3 * D;
    if (idx < 0 || idx >= NB6 + NB9) return;
    int lane_l; asm volatile("v_mbcnt_lo_u32_b32 %0, -1, 0\n\tv_mbcnt_hi_u32_b32 %0, -1, %0" : "=v"(lane_l)); const int r32 = lane_l & 31, hi = lane_l >> 5;
    bf16x8 bfr[8];
#define SD_LOADB(blk_) do { const bf16* w_ = ((blk_) < NB6) ? W6 + (size_t)((blk_) * 32 + r32) * D : W9 + (size_t)(((blk_) - NB6) * 32 + r32) * D; \
        _Pragma("unroll") for (int q = 0; q < 8; ++q) bfr[q] = *(const bf16x8*)(w_ + wave * 128 + q * 16 + hi * 8); } while (0)
    SD_LOADB(idx);
    int img = 0;
    for (int blk = idx; blk < NB6 + NB9; blk += nidle) { const int want = (blk < NB6) ? 1 : 2;
        if (img != want) { shift_img(want == 1 ? mod + 3 * D : mod + (size_t)17 * MODW, lds, tid); img = want; }
        f32x16_t acc;
#pragma unroll
        for (int i = 0; i < 16; ++i) acc[i] = 0.f;
#pragma unroll
        for (int q = 0; q < 8; ++q) { const bf16x8 a = *(const LAS bf16x8*)(lds + r32 * SD_PITCH + (wave * 128 + q * 16 + hi * 8) * 2);
            acc = __builtin_amdgcn_mfma_f32_32x32x16_bf16(a, bfr[q], acc, 0, 0, 0); }
        if (blk + nidle < NB6 + NB9) SD_LOADB(blk + nidle);
        LAS float* part = (LAS float*)(lds + SD_PART) + wave * (17 * 32);
#pragma unroll
        for (int r = 0; r < 9; ++r) { const int b = (r & 3) + 8 * (r >> 2) + 4 * hi; if (b < 17) part[b * 32 + r32] = acc[r]; }
        __syncthreads();
        float* c = (blk < NB6) ? c6 : c9; const int N = (blk < NB6) ? N6 : N9, n0 = ((blk < NB6) ? blk : blk - NB6) * 32;
        for (int i = tid; i < 17 * 32; i += NWAVES * 64) { float sum = 0.f;
#pragma unroll
            for (int w = 0; w < NWAVES; ++w) sum += ((LAS float*)(lds + SD_PART))[w * (17 * 32) + i];
            c[(size_t)(i >> 5) * N + n0 + (i & 31)] = sum; }
        __syncthreads();
    }
#undef SD_LOADB
}
struct Args { const float* in[30]; float* out; unsigned char* ws; };
__global__ void __launch_bounds__(NWAVES * 64, 2) mega_fwd(Args args) {
    extern __shared__ __attribute__((aligned(16))) unsigned char lds_raw[];
    LAS unsigned char* lds = (LAS unsigned char*)lds_raw;
    volatile LAS unsigned* MISC = (volatile LAS unsigned*)(lds + MISC_OFF);
    LAS int* tile_e = (LAS int*)(lds + TILE_E_OFF);
    LAS int* ebase = (LAS int*)(lds + EBASE_OFF);
    const int G = gridDim.x, bx = blockIdx.x, vcu = (G % 8 == 0) ? (bx % 8) * (G / 8) + bx / 8 : bx;
    const int NGW = G * NWAVES;
    const int wave = __builtin_amdgcn_readfirstlane(threadIdx.x >> 6);
#define PHASE_IDS() int lane_l; asm volatile("v_mbcnt_lo_u32_b32 %0, -1, 0\n\tv_mbcnt_hi_u32_b32 %0, -1, %0" : "=v"(lane_l)); const int lane = lane_l, tid = wave * 64 + lane, gw = vcu * NWAVES + wave; (void)gw
#define x_in (args.in[0])
#define c_in (args.in[1])
#define ctx_in (args.in[2])
#define cctx_in (args.in[3])
#define l0_wada (args.in[4])
#define l0_bada (args.in[5])
#define l0_nmix (args.in[6])
#define l0_wqkv (args.in[7])
#define l0_rpb (args.in[8])
#define l0_wo (args.in[9])
#define l0_nffn (args.in[10])
#define l0_wg (args.in[11])
#define l0_wu (args.in[12])
#define l0_wd (args.in[13])
#define l1_wada (args.in[14])
#define l1_bada (args.in[15])
#define l1_nmix (args.in[16])
#define l1_wqkv (args.in[17])
#define l1_lq1 (args.in[18])
#define l1_lk1 (args.in[19])
#define l1_lq2 (args.in[20])
#define l1_lk2 (args.in[21])
#define l1_subln (args.in[22])
#define l1_wo (args.in[23])
#define l1_nffn (args.in[24])
#define l1_wr (args.in[25])
#define l1_wg (args.in[26])
#define l1_wu (args.in[27])
#define l1_wd (args.in[28])
#define fnorm (args.in[29])
#define xlat (args.out)
#define xctx ((float*)(args.ws + WS_XCTX))
#define mod ((float*)(args.ws + WS_MOD))
#define rope ((float*)(args.ws + WS_ROPE))
#define tok_e ((int*)(args.ws + WS_TOKE))
#define tok_w ((float*)(args.ws + WS_TOKW))
#define tok_p ((int*)(args.ws + WS_TOKP))
#define tok_s ((int*)(args.ws + WS_TOKS))
#define W0gu8 ((unsigned char*)(args.ws + WS_W0GU8))
#define ACTX8 ((unsigned char*)(args.ws + WS_H) + (size_t)ML * D * 2)
#define W0qkv8 ((unsigned char*)(args.ws + WS_W0QKV))
#define W1qkv8 ((unsigned char*)(args.ws + WS_W0QKV + 3 * MiB))
#define W0o ((bf16*)(args.ws + WS_W0O))
#define W0gu ((bf16*)(args.ws + WS_W0GU))
#define W0d ((bf16*)(args.ws + WS_W0D))
#define W1qkv ((bf16*)(args.ws + WS_W1QKV))
#define W1o ((bf16*)(args.ws + WS_W1O))
#define WMgu ((unsigned char*)(args.ws + WS_WMGU))
#define WMd ((unsigned char*)(args.ws + WS_WMD))
#define Hb ((bf16*)(args.ws + WS_H))
#define Qb ((bf16*)(args.ws + WS_Q))
#define Kb ((bf16*)(args.ws + WS_K))
#define Vb ((bf16*)(args.ws + WS_V))
#define ACT0 ((bf16*)(args.ws + WS_ACT0))
#define APERM ((unsigned char*)(args.ws + WS_APERM))
#define YB ((bf16*)(args.ws + WS_Y))
#define H2 ((unsigned char*)(args.ws + WS_H2))
#define ACT1 ((unsigned char*)(args.ws + WS_ACT1))
#define ctl ((gu32*)(args.ws + WS_CTL))
#define SSQ ((float*)(args.ws + WS_SSQ))
#define C6 ((float*)(args.ws + WS_C6))
#define C9 ((float*)(args.ws + WS_C9))
    for (int u = threadIdx.x; u < (LDS_BYTES - LDSCTL_OFF) / 4; u += NWAVES * 64) ((LAS unsigned*)(lds + LDSCTL_OFF))[u] = 0u;
    __syncthreads();
    XcdBarrier bar = xcd_barrier_post((unsigned*)(ctl + CW_BAR), MISC + 8);
#define GRID_BAR() xcd_barrier(bar)
#define IDLE_CVT(NUNITS, LO, HI) do { const int rem_ = (NUNITS) % G;     \
        if (rem_ != 0 && bx >= rem_) moe_cvt_range((LO), (HI), (bx - rem_) * NWAVES + wave, (G - rem_) * NWAVES, l1_wg, l1_wu, l1_wd, WMgu, WMd, WSCALE, (LAS float*)(lds + RING_OFF + wave * 16384), lane); \
        else if (rem_ == 0) moe_cvt_range((LO), (HI), gw, NGW, l1_wg, l1_wu, l1_wd, WMgu, WMd, WSCALE, (LAS float*)(lds + RING_OFF + wave * 16384), lane); } while (0)
#define ODST_REAL Kb

    {
        PHASE_IDS();
        if (bx < 192) {
            typedef float f32x16_t __attribute__((ext_vector_type(16)));
            LAS float* sl = (LAS float*)(lds + RING_OFF); LAS float* red = (LAS float*)(lds + RING_OFF + 17 * 1025 * 4 + 60);
            for (int i = tid; i < 17 * 1024; i += NWAVES * 64) { const int r = i >> 10, k = i & 1023; const float cv = (r < 16) ? c_in[r * 1024 + k] : cctx_in[k]; sl[r * 1025 + k] = cv / (1.0f + __expf(-cv)); }
            __syncthreads();
            const int layer = bx / 96, n0 = (bx % 96) * 64, col = tid & 63, ks = tid >> 6, li = lane & 31, kh = lane >> 5;
            const float* W = (layer ? l1_wada : l0_wada) + n0 + li; const float* bias = (layer ? l1_bada : l0_bada);
            const LAS float* ap = sl + ((li < 17) ? li : 0) * 1025 + ks * 128 + kh;
            f32x16_t acc0, acc1;
#pragma unroll
            for (int r = 0; r < 16; ++r) { acc0[r] = 0.f; acc1[r] = 0.f; }
            for (int kk = 0; kk < 64; kk += 8) { float w0[8], w1[8], a[8];
#pragma unroll
                for (int i = 0; i < 8; ++i) { const float* wp = W + (size_t)(ks * 128 + 2 * (kk + i) + kh) * MODW; w0[i] = wp[0]; w1[i] = wp[32]; a[i] = (li < 17) ? ap[2 * (kk + i)] : 0.f; }
#pragma unroll
                for (int i = 0; i < 8; ++i) { acc0 = __builtin_amdgcn_mfma_f32_32x32x2f32(a[i], w0[i], acc0, 0, 0, 0); acc1 = __builtin_amdgcn_mfma_f32_32x32x2f32(a[i], w1[i], acc1, 0, 0, 0); } }
#pragma unroll
            for (int r = 0; r < 9; ++r) { const int row = (r & 3) + 8 * (r >> 2) + 4 * kh; if (row < 17) { red[(ks * 17 + row) * 64 + li] = acc0[r]; red[(ks * 17 + row) * 64 + 32 + li] = acc1[r]; } }
            __syncthreads();
            for (int i = tid; i < 17 * 64; i += NWAVES * 64) { const int r = i >> 6, cc = i & 63; float s = bias[n0 + cc];
#pragma unroll
                for (int q = 0; q < 8; ++q) s += red[(q * 17 + r) * 64 + cc];
                mod[(size_t)(layer * 17 + r) * MODW + n0 + cc] = s; }
            __syncthreads(); (void)col;
        }
        if (bx == 192 || (G <= 192 && bx == 0)) {
            for (int i = tid; i < 64 * 16; i += NWAVES * 64) { const int pos = i >> 4, f = i & 15; double inv = 1.0; for (int q = 0; q < f; ++q) inv *= 0.5623413251903491;
                const double a = (double)pos * inv; const double kq = __builtin_rint(a * 0.6366197723675814); const double rr = (a - kq * 1.5707963267948966) - kq * 6.123233995736766e-17; const double r2 = rr * rr;
                double sn = rr * (1.0 + r2 * (-1.0 / 6 + r2 * (1.0 / 120 + r2 * (-1.0 / 5040 + r2 * (1.0 / 362880 + r2 * (-1.0 / 39916800 + r2 * (1.0 / 6227020800.0)))))));
                double cn = 1.0 + r2 * (-0.5 + r2 * (1.0 / 24 + r2 * (-1.0 / 720 + r2 * (1.0 / 40320 + r2 * (-1.0 / 3628800 + r2 * (1.0 / 479001600.0 + r2 * (-1.0 / 87178291200.0)))))));
                const int qd = ((int)kq) & 3; double cs = cn, ss = sn; if (qd == 1) { cs = -sn; ss = cn; } else if (qd == 2) { cs = -cn; ss = -sn; } else if (qd == 3) { cs = sn; ss = -cn; }
                rope[2 * i] = (float)cs; rope[2 * i + 1] = (float)ss; }
        }
        LAS float* scr = (LAS float*)(lds + RING_OFF + wave * 16384);
        int itbase = 0;
#undef CVT
#define CVT(SRC, DST, KK, NN, MODE, NMAT, F8) do { const CvtMat cm_{SRC, DST, KK, NN, MODE, NMAT, F8}; const int nit_ = ((KK) / 64) * ((NN) / 32) * (NMAT); \
            int first_ = (gw - itbase) % NGW; if (first_ < 0) first_ += NGW; for (int it = first_; it < nit_; it += NGW) cvt_run(cm_, it, scr, lane); itbase += nit_; } while (0)
        CVT(l0_wqkv, W0qkv8, D, 3 * D, 0, 1, WSCALE); CVT(l1_wqkv, W1qkv8, D, 3 * D, 0, 1, WSCALE); CVT(l0_wo, W0o, D, D, 0, 1, WSCALE); CVT(l0_wg, W0gu, D, DFF, 1, 1, 0.f); CVT(l0_wu, W0gu, D, DFF, 2, 1, 0.f); CVT(l0_wd, W0d, DFF, D, 0, 1, WSCALE); CVT(l0_wg, W0gu8, D, DFF, 1, 1, WSCALE); CVT(l0_wu, W0gu8, D, DFF, 2, 1, WSCALE);
        CVT(l1_wqkv, W1qkv, D, 3 * D, 0, 1, 0.f); CVT(l1_wo, W1o, D, D, 0, 1, WSCALE);
        moe_cvt_range(MC5, MOE_ITEMS, ((gw - itbase) % NGW + NGW) % NGW, NGW, l1_wg, l1_wu, l1_wd, WMgu, WMd, WSCALE, scr, lane);
    }
    GRID_BAR();

    { PHASE_IDS();
    for (int m = gw; m < MT; m += 2 * NGW) { const int m2 = m + NGW; const bool lat = m < ML, has2 = m2 < MT, lat2 = has2 && m2 < ML; const int mb = has2 ? m2 : m;
        const float* mp = mod + (size_t)((lat ? (m >> 11) : 16)) * MODW; const float* mq = mod + (size_t)(((has2 ? lat2 : lat) ? (mb >> 11) : 16)) * MODW;
        norm_mod_row2<true>(lat ? x_in + (size_t)m * D : ctx_in + (size_t)(m - ML) * D, (has2 ? lat2 : lat) ? x_in + (size_t)mb * D : ctx_in + (size_t)(mb - ML) * D, l0_nmix, mp + 0, mp + D, mq + 0, mq + D, (unsigned char*)Hb + (size_t)m * D, (unsigned char*)Hb + (size_t)mb * D, lane); }
    }
    GRID_BAR();

    { PHASE_IDS(); pg8::Gemm g{Hb, (const pg8::bf16_t*)W0qkv8, MT, 3 * D, D / 2}; pg8::StaticOrder S; S.init(MT, 3 * D, G, bx);
      pg8::EpiQKV<false, false, true> E{Qb, (size_t)MT * D, nullptr, nullptr, 0, nullptr, 0, 1.0f / WSCALE, (unsigned char*)Qb, (size_t)MT * D};
      pg8::gemm_phase<pg8::EpiQKV<false, false, true>, pg8::StaticOrder, true, true, true>(lds + RING_OFF, g, S, E, tid);
      { const int nu = (MT / 256) * (3 * D / 256), rem = nu % G, nidle = rem ? G - rem : G, idx = rem ? bx - rem : bx;
        shift_dots(mod, W0gu, C6, W1qkv, C9, idx, nidle, lds + RING_OFF, wave, tid); } }
    GRID_BAR();

    { PHASE_IDS(); bf16* Odst = ODST_REAL;
    { const bool grp8 = (G & 7) == 0; const int ng = G >> 3, nctx = (NB * 16 + G - 1) / G, nlat = grp8 ? (NB * 16 + ng - 1) / ng : 0, total = grp8 ? nlat + nctx : 9 * nctx;
      int rpb_h = -1;
      for (int j = 0; j < total; ++j) { int bh, rg;
          if (grp8) { if (j < nlat) { bh = (vcu >> 3) + j * ng; rg = vcu & 7; } else { bh = vcu + (j - nlat) * G; rg = 8; } } else { bh = vcu + (j / 9) * G; rg = j % 9; }
          if (bh < NB * 16) { const bool ldt = rg < 8 && (bh & 15) != rpb_h; if (rg < 8) rpb_h = bh & 15;
              att::na_unit(bh >> 4, bh & 15, rg, (const unsigned char*)Qb, (const unsigned char*)Qb + (size_t)MT * D, Vb, Odst, l0_rpb, lds + RING_OFF, wave, ldt); } } } }
    GRID_BAR();

    { PHASE_IDS(); pg8::Gemm g{Kb, W0o, MT, D, D / 2}; pg8::StaticOrder S; S.init(ML, D, G, bx);
      pg8::EpiResidN E{x_in, ctx_in, xlat, xctx, mod + 2 * D, Hb, l0_nffn, mod + 4 * D, SSQ, 1.0f / WSCALE, MT};
      pg8::gemm_phase<pg8::EpiResidN, pg8::StaticOrder, true, true, true>(lds + RING_OFF, g, S, E, tid); }
    { PHASE_IDS(); pg8::Gemm g{Kb, W0o, MT, D, D / 2}; pg8::StaticOrderOff S; S.init(MC, D, G, bx); S.pm0 = ML / 256;
      pg8::EpiResidNT<true> E{x_in, ctx_in, xlat, xctx, mod + 2 * D, (bf16*)(ACTX8 - (size_t)ML * D), l0_nffn, mod + 4 * D, SSQ, 1.0f / WSCALE, MT};
      pg8::gemm_phase<pg8::EpiResidNT<true>, pg8::StaticOrderOff, true, true, true>(lds + RING_OFF, g, S, E, tid); }
    { PHASE_IDS(); IDLE_CVT((MC / 256) * (D / 256), MC1, MC2); }
    GRID_BAR();


    { PHASE_IDS(); pg8::Gemm g{Hb, W0gu, ML, 2 * DFF, D}; pg8::StaticOrder S; S.init(ML, 2 * DFF, G, bx);
      pg8::EpiSwiGLU8N E{(unsigned char*)ACT0, DFF, SSQ, MT, C6, 2 * DFF};
      pg8::gemm_phase<pg8::EpiSwiGLU8N, pg8::StaticOrder, true, true>(lds + RING_OFF, g, S, E, tid); }
    { PHASE_IDS(); pg8::Gemm g{(const pg8::bf16_t*)(ACTX8 - (size_t)ML * D), (const pg8::bf16_t*)W0gu8, MT, 2 * DFF, D / 2}; pg8::StaticOrderOff S; S.init(MC, 2 * DFF, G, bx); S.pm0 = ML / 256;
      pg8::EpiSwiGLU8N E{(unsigned char*)ACT0, DFF, SSQ, MT, C6, 2 * DFF, 1.0f / WSCALE};
      pg8::gemm_phase<pg8::EpiSwiGLU8N, pg8::StaticOrderOff, true, true, true>(lds + RING_OFF, g, S, E, tid); }
    { PHASE_IDS(); IDLE_CVT((MC / 256) * (2 * DFF / 256), MC2, MC3); }
    GRID_BAR();

    { PHASE_IDS(); pg8::Gemm g{ACT0, W0d, MT, D, DFF / 2}; pg8::StaticOrder S; S.init(MT, D, G, bx);
      pg8::EpiResidNT<true> E{xlat, xctx, xlat, xctx, mod + 5 * D, Hb, l1_nmix, mod + (size_t)17 * MODW + D, SSQ, 1.0f / WSCALE, MT};
      pg8::gemm_phase<pg8::EpiResidNT<true>, pg8::StaticOrder, true, true, true>(lds + RING_OFF, g, S, E, tid);
      IDLE_CVT((MT / 256) * (D / 256), MC3, MC4); }
    GRID_BAR();


    { PHASE_IDS(); pg8::Gemm g{Hb, (const pg8::bf16_t*)W1qkv8, MT, 3 * D, D / 2}; pg8::StaticOrder S; S.init(MT, 3 * D, G, bx);
      pg8::EpiQKV<true, true, true, true> E{Qb, (size_t)MT * D, rope, SSQ, MT, C9, 3 * D, 1.0f / WSCALE, (unsigned char*)Qb, (size_t)MT * D, (unsigned char*)Vb, lds + RING_OFF + pg8::STAGE_BYTES};
      pg8::gemm_phase<pg8::EpiQKV<true, true, true, true>, pg8::StaticOrder, true, true, true>(lds + RING_OFF, g, S, E, tid); }
    GRID_BAR();

    {
        PHASE_IDS(); bf16* Odst = Kb;
        float d1 = 0.f, d2 = 0.f; d1 = l1_lq1[lane] * l1_lk1[lane]; d2 = l1_lq2[lane] * l1_lk2[lane];
        int lam_i = __builtin_amdgcn_readfirstlane(__builtin_bit_cast(int, __expf(wave_sum(d1)) - __expf(wave_sum(d2)) + LAM_INIT)); const float lam = __builtin_bit_cast(float, lam_i);
        ((LAS float*)(lds + RING_OFF + att::L_WSF))[wave * 128 + 120] = lam;
        { const bool grp8 = (G & 7) == 0; const int ng = G >> 3, nbh = NB * 8, total = grp8 ? (nbh + ng - 1) / ng : (nbh * 8 + G - 1) / G;
          for (int j = 0; j < total; ++j) { int bh, qb; if (grp8) { bh = (vcu >> 3) + j * ng; qb = vcu & 7; } else { const int u = vcu * total + j; bh = u >> 3; qb = u & 7; }
              if (bh < nbh) att::diff_unit(bh >> 3, bh & 7, qb, (const unsigned char*)Qb, (const unsigned char*)Qb + (size_t)MT * D, (const unsigned char*)Vb, Odst, lam, 1.0f - LAM_INIT, l1_subln, lds + RING_OFF, wave); } }
    }
    GRID_BAR();

    { PHASE_IDS(); pg8::Gemm g{Kb, W1o, ML, D, D / 2}; pg8::StaticOrder S; S.init(ML, D, G, bx);
      pg8::EpiResid E{xlat, xctx, xlat, xctx, mod + (size_t)17 * MODW + 2 * D, 1.0f / WSCALE};
      pg8::gemm_phase<pg8::EpiResid, pg8::StaticOrder, true, true, true>(lds + RING_OFF, g, S, E, tid); }
    GRID_BAR();

#ifndef P12_MODE
#define P12_MODE 0
#endif
    {
        PHASE_IDS();
        LAS float* wrl = (LAS float*)(lds + RING_OFF);
        LAS int* lcnt = (LAS int*)(lds + RING_OFF + 32768);
        LAS int* rec = (LAS int*)(lds + RING_OFF + 32768 + 64);
        for (int i = tid; i < 8192; i += NWAVES * 64) { const int k = i >> 3, e = i & 7; wrl[(e >> 2) * 4096 + (((k >> 8) * 4 + (k & 3)) * 64 + ((k & 255) >> 2)) * 4 + (e & 3)] = l1_wr[i]; }
        if (tid < 16) lcnt[tid] = 0;
        __syncthreads();
        const int rows_per = (ML + G - 1) / G;
        const int row_lo = vcu * rows_per, row_hi = (row_lo + rows_per < ML) ? row_lo + rows_per : ML;
        const bool ub = (row_lo >> 11) == ((row_hi - 1) >> 11);
        f32x4 uu[4], shv[4];
        if (ub) { const float* mp0 = mod + (size_t)(17 + (row_lo >> 11)) * MODW;
#pragma unroll
            for (int j = 0; j < 4; ++j) { uu[j] = ((const f32x4*)l1_nffn)[lane + 64 * j] * (((const f32x4*)(mp0 + 4 * D))[lane + 64 * j] + 1.0f); shv[j] = ((const f32x4*)(mp0 + 3 * D))[lane + 64 * j]; } }
        f32x4 xq[3][4];
#pragma unroll
        for (int p_ = 0; p_ < 3; ++p_) { const int mr = row_lo + wave + p_ * NWAVES; if (mr < row_hi) { const GAS f32x4* xr = (const GAS f32x4*)(xlat + (size_t)mr * D) + lane;
#pragma unroll
            for (int j = 0; j < 4; ++j) xq[p_][j] = xr[64 * j]; } }
        for (int m0 = row_lo + wave; m0 < row_hi; m0 += 3 * NWAVES) {
#pragma unroll
          for (int p_ = 0; p_ < 3; ++p_) { const int m = m0 + p_ * NWAVES; if (m < row_hi) { const int br = m >> 11; const float* mp = mod + (size_t)(17 + br) * MODW; f32x4 v[4]; (void)mp;
#pragma unroll
            for (int j = 0; j < 4; ++j) v[j] = xq[p_][j];
            if (m + 3 * NWAVES < row_hi) { const GAS f32x4* xr = (const GAS f32x4*)(xlat + (size_t)(m + 3 * NWAVES) * D) + lane;
#pragma unroll
                for (int j = 0; j < 4; ++j) xq[p_][j] = xr[64 * j]; }
            if (ub) { float s2 = 0.f;
#pragma unroll
                for (int j = 0; j < 4; ++j) s2 += (v[j].x * v[j].x + v[j].y * v[j].y) + (v[j].z * v[j].z + v[j].w * v[j].w);
                const float rstd = 1.0f / sqrtf(wave_sum(s2) * (1.f / D) + EPS);
#pragma unroll
                for (int j = 0; j < 4; ++j) { v[j] = (v[j] * rstd) * uu[j] + shv[j]; ((GAS unsigned*)(H2 + (size_t)m * D))[lane + 64 * j] = pg8::pk4_fp8(v[j].x, v[j].y, v[j].z, v[j].w); } }
            else norm_mod_row<true, true>(xlat + (size_t)m * D, l1_nffn, mp + 3 * D, mp + 4 * D, H2 + (size_t)m * D, lane, v);
            if (P12_MODE != 1) {
            float lg[8];
#pragma unroll
            for (int e = 0; e < 8; ++e) lg[e] = 0.f;
#pragma unroll
            for (int j = 0; j < 4; ++j)
#pragma unroll
                for (int q = 0; q < 4; ++q) { const int k = 4 * lane + 256 * j + q; const f32x4 w0 = *(const LAS f32x4*)(wrl + ((j * 4 + q) * 64 + lane) * 4), w1 = *(const LAS f32x4*)(wrl + 4096 + ((j * 4 + q) * 64 + lane) * 4); const float hv = v[j][q]; (void)k;
                    lg[0] += hv * w0[0]; lg[1] += hv * w0[1]; lg[2] += hv * w0[2]; lg[3] += hv * w0[3]; lg[4] += hv * w1[0]; lg[5] += hv * w1[1]; lg[6] += hv * w1[2]; lg[7] += hv * w1[3]; }
#pragma unroll
            for (int e = 0; e < 8; ++e) lg[e] = wave_sum(lg[e]);
            int e0 = 0; float b0 = lg[0];
#pragma unroll
            for (int e = 1; e < 8; ++e) if (lg[e] > b0) { b0 = lg[e]; e0 = e; }
            int e1 = -1; float b1 = -INFINITY;
#pragma unroll
            for (int e = 0; e < 8; ++e) if (e != e0 && lg[e] > b1) { b1 = lg[e]; e1 = e; }
            if (lane == 0) { const float w0 = 1.0f / (1.0f + __expf(b1 - b0)); const int lr = m - row_lo;
                const int p0 = __hip_atomic_fetch_add(&lcnt[e0], 1, __ATOMIC_RELAXED, __HIP_MEMORY_SCOPE_WORKGROUP), p1 = __hip_atomic_fetch_add(&lcnt[e1], 1, __ATOMIC_RELAXED, __HIP_MEMORY_SCOPE_WORKGROUP);
                rec[lr * 6 + 0] = e0; rec[lr * 6 + 1] = e1; rec[lr * 6 + 2] = p0; rec[lr * 6 + 3] = p1; ((LAS float*)rec)[lr * 6 + 4] = w0; ((LAS float*)rec)[lr * 6 + 5] = 1.0f - w0; }
            }
          } }
        }
        __syncthreads();
        if (tid < 8) lcnt[8 + tid] = (int)__hip_atomic_fetch_add(ctl + CW_CNT + 64 * tid, (unsigned)lcnt[tid], RLX_AGENT);
        __syncthreads();
        for (int lr = tid; lr < row_hi - row_lo; lr += NWAVES * 64) { const int m = row_lo + lr; const int e0 = rec[lr * 6], e1 = rec[lr * 6 + 1];
            tok_e[2 * m] = e0; tok_e[2 * m + 1] = e1; tok_p[2 * m] = lcnt[8 + e0] + rec[lr * 6 + 2]; tok_p[2 * m + 1] = lcnt[8 + e1] + rec[lr * 6 + 3];
            tok_w[2 * m] = ((LAS float*)rec)[lr * 6 + 4]; tok_w[2 * m + 1] = ((LAS float*)rec)[lr * 6 + 5]; }
    }
    GRID_BAR();

    {
        PHASE_IDS();
        if (tid < 8) ebase[9 + tid] = (int)__hip_atomic_load(ctl + CW_CNT + 64 * tid, RLX_AGENT);
        __syncthreads();
        if (tid == 0) { int base = 0; for (int e = 0; e < 8; ++e) { ebase[e] = base; const int n = ebase[9 + e]; const int nt = (n + 255) >> 8;
                for (int t = 0; t < nt; ++t) tile_e[(base >> 8) + t] = e; base += nt << 8; } ebase[8] = base; }
        __syncthreads();
        for (int m = gw; m < ML; m += 4 * NGW) { v4u a[4]; int es[4][2], ps[4][2];
#pragma unroll
            for (int q = 0; q < 4; ++q) { const int mm = (m + q * NGW < ML) ? m + q * NGW : m; a[q] = ((const v4u*)(H2 + (size_t)mm * D))[lane];
                es[q][0] = tok_e[2 * mm]; es[q][1] = tok_e[2 * mm + 1]; ps[q][0] = tok_p[2 * mm]; ps[q][1] = tok_p[2 * mm + 1]; }
#pragma unroll
            for (int q = 0; q < 4; ++q) if (m + q * NGW < ML) { const int mm = m + q * NGW;
#pragma unroll
                for (int k = 0; k < 2; ++k) { const int slot = ebase[es[q][k]] + ps[q][k]; if (lane == 0) tok_s[2 * mm + k] = slot;
                    ((v4u*)(APERM + (size_t)slot * D))[lane] = a[q]; } } }
        for (int i = gw; i < 8 * 256; i += NGW) { const int e = i >> 8, j = i & 255, n = ebase[9 + e], pad = ebase[e + 1] - ebase[e] - n;
            if (j < pad) { const v4u z = {0u, 0u, 0u, 0u}; ((v4u*)(APERM + (size_t)(ebase[e] + n + j) * D))[lane] = z; } }
    }
    GRID_BAR();

    {
        const int T = ebase[8] >> 8;
        { PHASE_IDS(); pg8::Gemm g{(const pg8::bf16_t*)APERM, (const pg8::bf16_t*)WMgu, 0, 0, D / 2}; pg8::MoeOrder S; S.init(T, 2 * DFE / 256, G, vcu, tile_e);
          pg8::EpiSwiGLU8 E{ACT1, DFE, 0, tile_e, 2 * DFE / 256, 1.0f / WSCALE};
          pg8::gemm_phase<pg8::EpiSwiGLU8, pg8::MoeOrder, true, true, true>(lds + RING_OFF, g, S, E, tid); }
        GRID_BAR();
        { PHASE_IDS(); const int nun = T * (D / 256), Ltail0 = (nun / G) * G, ntail = nun - Ltail0; const bool split = ntail > 0 && ntail * 7 <= G && ntail <= 36;
          { pg8::Gemm g{(const pg8::bf16_t*)ACT1, (const pg8::bf16_t*)WMd, 0, 0, DFE / 2}; pg8::MoeOrder S; S.init(T, D / 256, G, vcu, tile_e); if (split) S.Lcap = Ltail0;
            pg8::EpiBf16GrpS E{YB, tile_e, D / 256, 1.0f / WSCALE};
            pg8::gemm_phase<pg8::EpiBf16GrpS, pg8::MoeOrder, true, true, true>(lds + RING_OFF, g, S, E, tid); }
          if (split && vcu < ntail * 7) { const int v = vcu / 7, q = vcu % 7; int ktn = 4; asm volatile("" : "+s"(ktn));
            pg8::Gemm g{(const pg8::bf16_t*)ACT1, (const pg8::bf16_t*)WMd, 0, 0, DFE / 2, ktn * q, ktn}; pg8::MoeOrder S; S.init(T, D / 256, 1 << 20, Ltail0 + v, tile_e);
            pg8::EpiPart E{(float*)(args.ws + WS_PART) + (size_t)(v * 7 + q) * 65536, 1.0f / WSCALE};
            pg8::gemm_phase<pg8::EpiPart, pg8::MoeOrder, true, true, true>(lds + RING_OFF, g, S, E, tid); } }
        GRID_BAR();
    }

    { PHASE_IDS();
    const int p18_T = ebase[8] >> 8, p18_nun = p18_T * (D / 256), p18_L0 = (p18_nun / G) * G, p18_nt = p18_nun - p18_L0, p18_Tf = p18_T & ~7, p18_nfl = p18_Tf * (D / 256);
    const bool p18_split = p18_nt > 0 && p18_nt * 7 <= G && p18_nt <= 36;
    const float* p18_part = (const float*)(args.ws + WS_PART);
#define P18_UL(s_, j) ((((s_) >> 8) < p18_Tf) ? ((((s_) >> 8) >> 3) * 32 + (j) * 8 + (((s_) >> 8) & 7)) : (p18_nfl + (((s_) >> 8) - p18_Tf) * 4 + (j)))
#define P18_SUM(s_, j) ({ const float* pp_ = p18_part + (size_t)(P18_UL(s_, j) - p18_L0) * 7 * 65536 + (size_t)((s_) & 255) * 256 + 4 * lane; f32x4 acc_ = *(const f32x4*)pp_; \
        _Pragma("unroll") for (int q_ = 1; q_ < 7; ++q_) acc_ = acc_ + *(const f32x4*)(pp_ + (size_t)q_ * 65536); acc_; })
#define P18_BF(a, o) do { o.x = __uint_as_float((unsigned)(a) << 16); o.y = __uint_as_float((unsigned)(a) & 0xffff0000u); o.z = __uint_as_float((unsigned)((a) >> 32) << 16); o.w = __uint_as_float((unsigned)((a) >> 32) & 0xffff0000u); } while (0)
    for (int m = gw; m < ML; m += 2 * NGW) { const int mb = (m + NGW < ML) ? m + NGW : m;
        const float* g2a = mod + (size_t)(17 + (m >> 11)) * MODW + 5 * D; const float* g2b = mod + (size_t)(17 + (mb >> 11)) * MODW + 5 * D;
        const int sa0 = tok_s[2 * m], sa1 = tok_s[2 * m + 1], sb0 = tok_s[2 * mb], sb1 = tok_s[2 * mb + 1]; const float wa0 = tok_w[2 * m], wa1 = tok_w[2 * m + 1], wb0 = tok_w[2 * mb], wb1 = tok_w[2 * mb + 1];
        GAS f32x4* xa = (GAS f32x4*)(xlat + (size_t)m * D) + lane; GAS f32x4* xb = (GAS f32x4*)(xlat + (size_t)mb * D) + lane;
        const unsigned long long* ya0 = (const unsigned long long*)(YB + (size_t)sa0 * D) + lane; const unsigned long long* ya1 = (const unsigned long long*)(YB + (size_t)sa1 * D) + lane;
        const unsigned long long* yb0 = (const unsigned long long*)(YB + (size_t)sb0 * D) + lane; const unsigned long long* yb1 = (const unsigned long long*)(YB + (size_t)sb1 * D) + lane;
        f32x4 va[4], vb[4]; unsigned long long qa0[4], qa1[4], qb0[4], qb1[4];
#pragma unroll
        for (int j = 0; j < 4; ++j) { va[j] = xa[64 * j]; vb[j] = xb[64 * j]; qa0[j] = ya0[64 * j]; qa1[j] = ya1[64 * j]; qb0[j] = yb0[64 * j]; qb1[j] = yb1[64 * j]; }
        float ssa = 0.f, ssb = 0.f;
        const bool anyt = p18_split && (P18_UL(sa0, 3) >= p18_L0 || P18_UL(sa1, 3) >= p18_L0 || P18_UL(sb0, 3) >= p18_L0 || P18_UL(sb1, 3) >= p18_L0);
#pragma unroll
        for (int j = 0; j < 4; ++j) { f32x4 p, q; const f32x4 ga = ((const f32x4*)g2a)[lane + 64 * j], gb = ((const f32x4*)g2b)[lane + 64 * j];
            P18_BF(qa0[j], p); P18_BF(qa1[j], q);
            if (anyt) { if (P18_UL(sa0, j) >= p18_L0) p = P18_SUM(sa0, j); if (P18_UL(sa1, j) >= p18_L0) q = P18_SUM(sa1, j); }
            va[j] = va[j] + ga * (p * wa0 + q * wa1); ssa += (va[j].x * va[j].x + va[j].y * va[j].y) + (va[j].z * va[j].z + va[j].w * va[j].w);
            P18_BF(qb0[j], p); P18_BF(qb1[j], q);
            if (anyt) { if (P18_UL(sb0, j) >= p18_L0) p = P18_SUM(sb0, j); if (P18_UL(sb1, j) >= p18_L0) q = P18_SUM(sb1, j); }
            vb[j] = vb[j] + gb * (p * wb0 + q * wb1); ssb += (vb[j].x * vb[j].x + vb[j].y * vb[j].y) + (vb[j].z * vb[j].z + vb[j].w * vb[j].w); }
        ssa += xl::swz_xor<1>(ssa); ssb += xl::swz_xor<1>(ssb); ssa += xl::swz_xor<2>(ssa); ssb += xl::swz_xor<2>(ssb); ssa += xl::swz_xor<4>(ssa); ssb += xl::swz_xor<4>(ssb);
        ssa += xl::swz_xor<8>(ssa); ssb += xl::swz_xor<8>(ssb); ssa += xl::swz_xor<16>(ssa); ssb += xl::swz_xor<16>(ssb); ssa = xl::half_sum(ssa); ssb = xl::half_sum(ssb);
        const float ra = 1.0f / sqrtf(ssa * (1.f / D) + EPS), rb = 1.0f / sqrtf(ssb * (1.f / D) + EPS);
#pragma unroll
        for (int j = 0; j < 4; ++j) { const f32x4 fn = ((const f32x4*)fnorm)[lane + 64 * j]; xa[64 * j] = va[j] * ra * fn; if (mb != m) xb[64 * j] = vb[j] * rb * fn; }
    }
#undef P18_BF
#undef P18_UL
#undef P18_SUM
    }
#undef GRID_BAR
}

extern "C" void kernel_launch(void* const* d_in, const int* in_sizes, int n_in, void* d_out, int out_size, void* d_ws, size_t ws_size, hipStream_t stream) {
    static int grid = 0;
    if (grid == 0) {
        if (n_in != 30 || out_size != ML * D || ws_size < WS_END2) { fprintf(stderr, "kernel_launch: built for 30 inputs, out of %d floats, >= %zu bytes of workspace; got n_in %d, out %d, ws %zu; nothing launched\n", ML * D, (size_t)WS_END2, n_in, out_size, ws_size); grid = -1; return; }
        int dev = 0, cus = 0, per_cu = 0;
        if (hipGetDevice(&dev) != hipSuccess || hipDeviceGetAttribute(&cus, hipDeviceAttributeMultiprocessorCount, dev) != hipSuccess) { grid = -1; return; }
        if (hipFuncSetAttribute((const void*)mega_fwd, hipFuncAttributeMaxDynamicSharedMemorySize, LDS_BYTES) != hipSuccess) { fprintf(stderr, "kernel_launch: hipFuncSetAttribute failed\n"); grid = -1; return; }
        if (hipOccupancyMaxActiveBlocksPerMultiprocessor(&per_cu, (const void*)mega_fwd, NWAVES * 64, LDS_BYTES) != hipSuccess || per_cu < 1)
            fprintf(stderr, "kernel_launch: note: occupancy query reports %d workgroups per CU\n", per_cu);
        (void)hipGetLastError();
        grid = cus;
    }
    if (grid < 0) return;
    if (hipMemsetAsync((char*)d_ws + WS_CTL, 0, CTL_ZERO_BYTES, stream) != hipSuccess) return;
    Args a{};
    for (int i = 0; i < 30; ++i) a.in[i] = (const float*)d_in[i];
    a.out = (float*)d_out; a.ws = (unsigned char*)d_ws;
    hipLaunchKernelGGL(mega_fwd, dim3(grid), dim3(NWAVES * 64), LDS_BYTES, stream, a);
}
```
